# Optimizing an MI355X kernel written in HIP

```python
import jax, jax.numpy as jnp
from jax import lax
import numpy as np

D_MODEL = 1024
BATCH = 4
SEQ = 4096
DEPTH = 1

POOL_WIDTH = D_MODEL // 2
POOL_WINDOWS = (2, 4, 8, 16)
POOL_GROUP = POOL_WIDTH // len(POOL_WINDOWS)
LRU_WIDTH = D_MODEL - POOL_WIDTH
LRU_HEADS = 8
LRU_HEAD_DIM = LRU_WIDTH // LRU_HEADS
CONV_WIDTH = 4
LRU_C = 8.0
MIX_WIDTH = POOL_WIDTH + LRU_WIDTH
IN_WIDTH = POOL_WIDTH + 2 * LRU_WIDTH
D_FF = ((8 * D_MODEL // 3 + 255) // 256) * 256
EPS = 1e-6

kernel_name = "hymba_pool_rglru_block"


def rmsnorm(x, g):
    xf = x.astype(jnp.float32)
    y = xf * lax.rsqrt(jnp.mean(xf * xf, axis=-1, keepdims=True) + EPS)
    return (y * g.astype(jnp.float32)).astype(x.dtype)


def pool_mixer(u, pool_w, pool_scale):
    B, S, _ = u.shape
    uf = u.astype(jnp.float32)
    pos = jnp.arange(1, S + 1, dtype=jnp.float32)[None, :, None]
    outs = []
    for g, w in enumerate(POOL_WINDOWS):
        ug = uf[..., g * POOL_GROUP:(g + 1) * POOL_GROUP]
        cs = jnp.cumsum(ug, axis=1)
        lag = jnp.pad(cs[:, :S - w], ((0, 0), (w, 0), (0, 0)))
        mean = (cs - lag) / jnp.minimum(pos, float(w))
        outs.append(mean - ug)
    d = jnp.stack(outs, axis=2)
    y = jnp.einsum('bsgc,gcd->bsgd', d, pool_w.astype(jnp.float32)).reshape(B, S, POOL_WIDTH)
    return (y * pool_scale.astype(jnp.float32)).astype(u.dtype)


def causal_depthwise_conv(u, w, b):
    C = u.shape[-1]
    y = lax.conv_general_dilated(
        u, w[:, None, :].astype(u.dtype), window_strides=(1,),
        padding=[(CONV_WIDTH - 1, 0)], dimension_numbers=('NWC', 'WIO', 'NWC'),
        feature_group_count=C)
    return y + b.astype(u.dtype)


def _lin_combine(c1, c2):
    a1, b1 = c1
    a2, b2 = c2
    return a1 * a2, a2 * b1 + b2


def rg_lru(xc, w_a, b_a, w_i, b_i, lam):
    B, S, C = xc.shape
    xf = xc.astype(jnp.float32)
    xh = xf.reshape(B, S, LRU_HEADS, LRU_HEAD_DIM)
    r = jax.nn.sigmoid(jnp.einsum('bshc,hcd->bshd', xh, w_a.astype(jnp.float32)).reshape(B, S, C) + b_a.astype(jnp.float32))
    i = jax.nn.sigmoid(jnp.einsum('bshc,hcd->bshd', xh, w_i.astype(jnp.float32)).reshape(B, S, C) + b_i.astype(jnp.float32))
    log_a = -LRU_C * r * jax.nn.softplus(-lam.astype(jnp.float32))
    a = jnp.exp(log_a)
    mult = jnp.sqrt(jnp.maximum(-jnp.expm1(2.0 * log_a), 0.0))
    bterm = mult * (i * xf)
    _, h = lax.associative_scan(_lin_combine, (a, bterm), axis=1)
    return h.astype(xc.dtype)


def setup_inputs(seed: int = 0) -> dict:
    key = jax.random.key(seed)
    ks = jax.random.split(key, 24)
    f32 = jnp.float32

    def nrm(k, shape, fan_in):
        return jax.random.normal(k, shape, f32) * (fan_in ** -0.5)

    def gain(k, shape):
        return 1.0 + 0.05 * jax.random.normal(k, shape, f32)

    x = jax.random.normal(ks[0], (BATCH, SEQ, D_MODEL), f32)
    ln1_g = gain(ks[1], (DEPTH, D_MODEL))
    w_in = nrm(ks[2], (DEPTH, D_MODEL, IN_WIDTH), D_MODEL)
    pool_w = nrm(ks[3], (DEPTH, len(POOL_WINDOWS), POOL_GROUP, POOL_GROUP), POOL_GROUP)
    pool_scale = 1.0 + 0.1 * jax.random.normal(ks[4], (DEPTH, POOL_WIDTH), f32)
    conv_w = nrm(ks[5], (DEPTH, CONV_WIDTH, LRU_WIDTH), CONV_WIDTH)
    conv_b = 0.02 * jax.random.normal(ks[6], (DEPTH, LRU_WIDTH), f32)
    w_a = nrm(ks[7], (DEPTH, LRU_HEADS, LRU_HEAD_DIM, LRU_HEAD_DIM), LRU_HEAD_DIM)
    b_a = 0.02 * jax.random.normal(ks[8], (DEPTH, LRU_WIDTH), f32)
    w_i = nrm(ks[9], (DEPTH, LRU_HEADS, LRU_HEAD_DIM, LRU_HEAD_DIM), LRU_HEAD_DIM)
    b_i = 0.02 * jax.random.normal(ks[10], (DEPTH, LRU_WIDTH), f32)
    u = jax.random.uniform(ks[11], (DEPTH, LRU_WIDTH), f32, minval=0.9, maxval=0.999)
    s = u ** (1.0 / LRU_C)
    lam = jnp.log(s) - jnp.log1p(-s)
    gn_pool_g = gain(ks[12], (DEPTH, POOL_WIDTH))
    gn_lru_g = gain(ks[13], (DEPTH, LRU_WIDTH))
    w_out = nrm(ks[14], (DEPTH, MIX_WIDTH, D_MODEL), MIX_WIDTH)
    ln2_g = gain(ks[15], (DEPTH, D_MODEL))
    w_ffn_gate = nrm(ks[16], (DEPTH, D_MODEL, D_FF), D_MODEL)
    w_ffn_up = nrm(ks[17], (DEPTH, D_MODEL, D_FF), D_MODEL)
    w_ffn_down = nrm(ks[18], (DEPTH, D_FF, D_MODEL), D_FF)
    lnf_g = gain(ks[19], (D_MODEL,))
    return {"x": x, "ln1_g": ln1_g, "w_in": w_in, "pool_w": pool_w, "pool_scale": pool_scale,
            "conv_w": conv_w, "conv_b": conv_b, "w_a": w_a, "b_a": b_a, "w_i": w_i, "b_i": b_i,
            "lam": lam, "gn_pool_g": gn_pool_g, "gn_lru_g": gn_lru_g, "w_out": w_out,
            "ln2_g": ln2_g, "w_ffn_gate": w_ffn_gate, "w_ffn_up": w_ffn_up,
            "w_ffn_down": w_ffn_down, "lnf_g": lnf_g}


def reference(x, ln1_g, w_in, pool_w, pool_scale, conv_w, conv_b, w_a, b_a, w_i, b_i,
              lam, gn_pool_g, gn_lru_g, w_out, ln2_g, w_ffn_gate, w_ffn_up, w_ffn_down, lnf_g):
    h = x
    for l in range(DEPTH):
        n = rmsnorm(h, ln1_g[l])
        proj = n @ w_in[l]
        u_pool = proj[..., :POOL_WIDTH]
        u_lru = proj[..., POOL_WIDTH:POOL_WIDTH + LRU_WIDTH]
        u_gate = proj[..., POOL_WIDTH + LRU_WIDTH:]
        y_pool = pool_mixer(u_pool, pool_w[l], pool_scale[l])
        xc = causal_depthwise_conv(u_lru, conv_w[l], conv_b[l])
        y_lru = rg_lru(xc, w_a[l], b_a[l], w_i[l], b_i[l], lam[l]) * jax.nn.gelu(u_gate)
        mix = jnp.concatenate([rmsnorm(y_pool, gn_pool_g[l]), rmsnorm(y_lru, gn_lru_g[l])], axis=-1)
        h = h + mix @ w_out[l]
        n2 = rmsnorm(h, ln2_g[l])
        h = h + (jax.nn.silu(n2 @ w_ffn_gate[l]) * (n2 @ w_ffn_up[l])) @ w_ffn_down[l]
    return rmsnorm(h, lnf_g)
```

```cpp
#include <hip/hip_runtime.h>
#include <hip/hip_cooperative_groups.h>
#include <cstdio>
#include <cstdint>
namespace cg = cooperative_groups;
namespace pg8 {
#define PG8_LAS __attribute__((address_space(3)))
typedef unsigned short bf16_t;
typedef short bf16x8 __attribute__((ext_vector_type(8)));
typedef float f32x4 __attribute__((ext_vector_type(4)));
typedef unsigned u32x4 __attribute__((ext_vector_type(4)));
constexpr int BM = 256, BK = 64, HALF = 128, HTB = HALF * BK * 2  , STAGE_BYTES = 8 * HTB, NXCD = 8, WGM = 8;

__host__ __device__ __forceinline__ int lds_byte(int r, int c) { const int st = (r >> 4) * 2 + (c >> 5), rr = r & 15, cc = c & 31, ob = rr * 64 + cc * 2; return st * 1024 + (ob ^ (((ob >> 9) & 1) << 5)); }
__host__ __device__ __forceinline__ void stage_rc(int b, int& R, int& C) { const int st = b / 1024, sb = b % 1024, swz = sb ^ (((sb >> 9) & 1) << 5); R = (st >> 1) * 16 + swz / 64; C = (st & 1) * 32 + (swz % 64) / 2; }
__host__ __device__ __forceinline__ int perm32(int rho) { const int n = rho >> 4, i = rho & 15; return 8 * (i >> 2) + 4 * n + (i & 3); }

struct Unit { int pm, pn; };
struct Gemm { const bf16_t* A; const bf16_t* Bt; int M, N, K; };

struct StaticOrder {
    int nM, nN, nwg, G, c;
    __host__ __device__ void init(int M, int N, int G_, int c_) { nM = M / BM; nN = N / BM; nwg = nM * nN; G = G_; c = c_; }
    __host__ __device__ bool next(int i, Unit& u) const {
        const long L = (long)i * G + c; if (L >= nwg) return false;
        int wgid = (int)L; { const int q = nwg / NXCD, r = nwg % NXCD, xcd = wgid % NXCD, off = wgid / NXCD; wgid = (xcd < r ? xcd * (q + 1) : r * (q + 1) + (xcd - r) * q) + off; }
        const int nig = WGM * nN, gid = wgid / nig, fm = gid * WGM, gsz = (nM - fm) < WGM ? (nM - fm) : WGM;
        u.pm = fm + ((wgid % nig) % gsz); u.pn = (wgid % nig) / gsz; return true;
    }
    __device__ __forceinline__ void a_ready(const Unit&) const {}
    __device__ __forceinline__ void done(const Unit&) const {}
};

__device__ __forceinline__ unsigned cvt_pk_bf16(float lo, float hi) { unsigned r; asm volatile("v_cvt_pk_bf16_f32 %0, %1, %2" : "=v"(r) : "v"(lo), "v"(hi)); return r; }
typedef unsigned u32x2 __attribute__((ext_vector_type(2)));
struct EpiStoreBf16 {
    static constexpr bool PERM = true, AFTER_DRAIN = false;
    bf16_t* O; int ldc;
    __device__ __forceinline__ void operator()(const f32x4 (&acc)[2][2][4][2], const Unit& u, int wr, int wc, int fr, int fq) const {
        const int row0 = u.pm * BM + wr * 64 + fr, col0 = u.pn * BM + wc * 32 + 8 * fq;
#pragma unroll
        for (int ai = 0; ai < 2; ++ai)
#pragma unroll
            for (int m = 0; m < 4; ++m) { bf16_t* rowp = O + (size_t)(row0 + ai * HALF + m * 16) * ldc + col0;
#pragma unroll
                for (int bj = 0; bj < 2; ++bj) { const f32x4 v0 = acc[ai][bj][m][0], v1 = acc[ai][bj][m][1];
                    u32x4 w; w.x = cvt_pk_bf16(v0[0], v0[1]); w.y = cvt_pk_bf16(v0[2], v0[3]); w.z = cvt_pk_bf16(v1[0], v1[1]); w.w = cvt_pk_bf16(v1[2], v1[3]);
                    *(u32x4*)(rowp + bj * HALF) = w; } }
    }
};
struct EpiSwiGLU {
    static constexpr bool PERM = true, AFTER_DRAIN = false;
    bf16_t* O; int ldo; const float* sumsq; float inv_n, eps;
    __device__ __forceinline__ void operator()(const f32x4 (&acc)[2][2][4][2], const Unit& u, int wr, int wc, int fr, int fq) const {
        const int row0 = u.pm * BM + wr * 64 + fr, col0 = u.pn * HALF + wc * 32 + 8 * fq;
#pragma unroll
        for (int ai = 0; ai < 2; ++ai)
#pragma unroll
            for (int m = 0; m < 4; ++m) { const int row = row0 + ai * HALF + m * 16;
                const float rs = __builtin_amdgcn_rsqf(sumsq[row] * inv_n + eps);
                float o[8];
#pragma unroll
                for (int n = 0; n < 2; ++n)
#pragma unroll
                    for (int j = 0; j < 4; ++j) { const float g = acc[ai][0][m][n][j] * rs, up = acc[ai][1][m][n][j] * rs;
                        o[n * 4 + j] = g * __builtin_amdgcn_rcpf(1.0f + __expf(-g)) * up; }
                u32x4 w; w.x = cvt_pk_bf16(o[0], o[1]); w.y = cvt_pk_bf16(o[2], o[3]); w.z = cvt_pk_bf16(o[4], o[5]); w.w = cvt_pk_bf16(o[6], o[7]);
                *(u32x4*)(O + (size_t)row * ldo + col0) = w; }
    }
};
template <bool WITH_HB> struct EpiResid {
    static constexpr bool PERM = false, AFTER_DRAIN = false;
    const float* base; float* out; bf16_t* hb; const float* g; float* sumsq; int ldc;
    __device__ __forceinline__ void operator()(const f32x4 (&acc)[2][2][4][2], const Unit& u, int wr, int wc, int fr, int fq) const {
        const int col0 = u.pn * BM + wc * 32 + 4 * fq;
        f32x4 gv[2][2];
        if (WITH_HB) {
#pragma unroll
            for (int bj = 0; bj < 2; ++bj)
#pragma unroll
                for (int n = 0; n < 2; ++n) gv[bj][n] = *(const f32x4*)(g + col0 + bj * HALF + n * 16);
        }
#pragma unroll
        for (int ai = 0; ai < 2; ++ai)
#pragma unroll
            for (int m = 0; m < 4; ++m) { const int r = u.pm * BM + ai * HALF + wr * 64 + m * 16 + fr; const size_t off = (size_t)r * ldc + col0; float ss = 0.f;
#pragma unroll
                for (int bj = 0; bj < 2; ++bj)
#pragma unroll
                    for (int n = 0; n < 2; ++n) { const f32x4 bs = *(const f32x4*)(base + off + bj * HALF + n * 16); const f32x4 h = bs + acc[ai][bj][m][n];
                        *(f32x4*)(out + off + bj * HALF + n * 16) = h; ss += (h[0] * h[0] + h[1] * h[1]) + (h[2] * h[2] + h[3] * h[3]);
                        if (WITH_HB) { const f32x4 hg = h * gv[bj][n]; u32x2 w; w.x = cvt_pk_bf16(hg[0], hg[1]); w.y = cvt_pk_bf16(hg[2], hg[3]); *(u32x2*)(hb + off + bj * HALF + n * 16) = w; } }
                ss += __shfl_xor(ss, 16); ss += __shfl_xor(ss, 32);
                if (fq == 0) atomicAdd(sumsq + r, ss);
                if (m & 1) asm volatile("" ::: "memory"); }
    }
};
template <class Epi, class Sched, bool ALIGN_EPI = false, bool SP2 = false>
__device__ __forceinline__ void gemm_phase(PG8_LAS unsigned char* lds, const Gemm g, const Sched& S, const Epi& E) {
    const int tid = threadIdx.x, wid = __builtin_amdgcn_readfirstlane(tid >> 6), lane = tid & 63, wr = wid >> 2, wc = wid & 3, fr = lane & 15, fq = lane >> 4;
    const int K = g.K, nt = K / BK;
    unsigned voffA[2], voffB[2];
#pragma unroll
    for (int i = 0; i < 2; ++i) { int R, C; stage_rc(tid * 16 + i * 8192, R, C); const int Rb = Epi::PERM ? ((R & ~31) + perm32(R & 31)) : R;
        voffA[i] = (unsigned)(R * K + C) * 2u; voffB[i] = (unsigned)(Rb * K + C) * 2u; }
    const size_t kstep = (size_t)(BK * 2);
    const size_t hstep = (size_t)HALF * K * 2;
    const size_t tstep = 2 * hstep;
    const unsigned ldsw = (unsigned)wid * 1024u;
    const int aoff = lds_byte(wr * 64 + fr, fq * 8), boff = lds_byte(wc * 32 + fr, fq * 8);
#define PG8_SA(b, h) (((b) * 2 + (h)) * HTB)
#define PG8_SB(b, h) ((4 + (b) * 2 + (h)) * HTB)
#define PG8_STAGE(bufoff, gbase, voff) do { _Pragma("unroll") for (int _i = 0; _i < 2; ++_i) \
        __builtin_amdgcn_global_load_lds((const unsigned*)((const char*)(gbase) + (voff)[_i]), (PG8_LAS unsigned*)(lds + (bufoff) + ldsw + _i * 8192), 16, 0, 0); } while (0)
#define PG8_LDA(dst, b, h) do { _Pragma("unroll") for (int m = 0; m < 4; ++m) _Pragma("unroll") for (int k = 0; k < 2; ++k) dst[m][k] = *(const PG8_LAS bf16x8*)(lds + PG8_SA(b, h) + aoff + m * 2048 + k * 1024); } while (0)
#define PG8_LDB(dst, b, h) do { _Pragma("unroll") for (int n = 0; n < 2; ++n) _Pragma("unroll") for (int k = 0; k < 2; ++k) dst[n][k] = *(const PG8_LAS bf16x8*)(lds + PG8_SB(b, h) + boff + n * 2048 + k * 1024); } while (0)
#define PG8_MMA(ai, bj, At, Bt) do { __builtin_amdgcn_s_setprio(1); _Pragma("unroll") for (int m = 0; m < 4; ++m) _Pragma("unroll") for (int n = 0; n < 2; ++n) _Pragma("unroll") for (int k = 0; k < 2; ++k) \
        acc[ai][bj][m][n] = __builtin_amdgcn_mfma_f32_16x16x32_bf16(Bt[n][k], At[m][k], acc[ai][bj][m][n], 0, 0, 0); __builtin_amdgcn_s_setprio(0); } while (0)
#define PG8_WAIT_V(n) asm volatile("s_waitcnt vmcnt(" #n ")" ::: "memory")
#define PG8_WAIT_L(n) asm volatile("s_waitcnt lgkmcnt(" #n ")" ::: "memory")
#define PG8_BAR __builtin_amdgcn_s_barrier()
#define PG8_SCHED __builtin_amdgcn_sched_barrier(0)
    Unit cur, nxt; int ui = 0;
    if (!S.next(0, cur)) return;
    f32x4 acc[2][2][4][2];
#pragma unroll
    for (int a = 0; a < 2; ++a)
#pragma unroll
        for (int b = 0; b < 2; ++b)
#pragma unroll
            for (int m = 0; m < 4; ++m)
#pragma unroll
                for (int n = 0; n < 2; ++n) acc[a][b][m][n] = (f32x4){0.f, 0.f, 0.f, 0.f};
    bf16x8 At[4][2], B0[2][2], B1[2][2];
    const char* cA = (const char*)g.A + (size_t)cur.pm * tstep; const char* cB = (const char*)g.Bt + (size_t)cur.pn * tstep;
    S.a_ready(cur);
    if constexpr (SP2) {
        PG8_STAGE(PG8_SB(0, 0), cB, voffB); PG8_STAGE(PG8_SB(0, 1), cB + hstep, voffB); PG8_STAGE(PG8_SA(0, 0), cA, voffA); PG8_STAGE(PG8_SA(0, 1), cA + hstep, voffA);
        if (wr == 1) PG8_BAR;
        PG8_WAIT_V(2); PG8_BAR;
        PG8_STAGE(PG8_SB(1, 0), cB + kstep, voffB); PG8_STAGE(PG8_SA(1, 0), cA + kstep, voffA); PG8_STAGE(PG8_SB(1, 1), cB + hstep + kstep, voffB);
        PG8_WAIT_V(6); PG8_BAR;
    } else {
        PG8_STAGE(PG8_SB(0, 0), cB, voffB); PG8_STAGE(PG8_SA(0, 0), cA, voffA); PG8_STAGE(PG8_SB(0, 1), cB + hstep, voffB); PG8_STAGE(PG8_SA(0, 1), cA + hstep, voffA);
        if (wr == 1) PG8_BAR;
        PG8_WAIT_V(4); PG8_BAR;
        PG8_STAGE(PG8_SB(1, 0), cB + kstep, voffB); PG8_STAGE(PG8_SA(1, 0), cA + kstep, voffA); PG8_STAGE(PG8_SB(1, 1), cB + hstep + kstep, voffB);
        PG8_WAIT_V(6); PG8_BAR;
    }
    for (;;) {
        const bool has_next = S.next(ui + 1, nxt);
        const char* nA = has_next ? (const char*)g.A + (size_t)nxt.pm * tstep : cA; const char* nB = has_next ? (const char*)g.Bt + (size_t)nxt.pn * tstep : cB;
        for (int t = 0; t < nt; t += 2) {
            const bool last = (t == nt - 2);
            const char* a1 = cA + (size_t)(t + 1) * kstep;
            const char* a2 = last ? nA : cA + (size_t)(t + 2) * kstep; const char* b2 = last ? nB : cB + (size_t)(t + 2) * kstep;
            const char* a3 = a2 + kstep; const char* b3 = b2 + kstep;
            if (last && has_next) S.a_ready(nxt);
            if constexpr (SP2) {
            PG8_LDB(B0, 0, 0); PG8_LDB(B1, 0, 1); PG8_SCHED; PG8_LDA(At, 0, 0); PG8_STAGE(PG8_SA(1, 1), a1 + hstep, voffA);
            PG8_WAIT_V(8); PG8_WAIT_L(0); PG8_BAR; PG8_MMA(0, 0, At, B0); PG8_MMA(0, 1, At, B1); PG8_BAR; PG8_SCHED;
            PG8_LDA(At, 0, 1); PG8_STAGE(PG8_SB(0, 0), b2, voffB); PG8_STAGE(PG8_SB(0, 1), b2 + hstep, voffB); PG8_STAGE(PG8_SA(0, 0), a2, voffA);
            PG8_WAIT_V(8); PG8_WAIT_L(0); PG8_BAR; PG8_MMA(1, 0, At, B0); PG8_MMA(1, 1, At, B1); PG8_BAR; PG8_SCHED;
            PG8_LDB(B0, 1, 0); PG8_LDB(B1, 1, 1); PG8_SCHED; PG8_LDA(At, 1, 0); PG8_STAGE(PG8_SA(0, 1), a2 + hstep, voffA);
            PG8_WAIT_V(8); PG8_WAIT_L(0); PG8_BAR; PG8_MMA(0, 0, At, B0); PG8_MMA(0, 1, At, B1); PG8_BAR; PG8_SCHED;
            PG8_LDA(At, 1, 1); PG8_STAGE(PG8_SB(1, 0), b3, voffB); PG8_STAGE(PG8_SB(1, 1), b3 + hstep, voffB); PG8_STAGE(PG8_SA(1, 0), a3, voffA);
            PG8_WAIT_V(8); PG8_WAIT_L(0); PG8_BAR; PG8_MMA(1, 0, At, B0); PG8_MMA(1, 1, At, B1); PG8_BAR; PG8_SCHED;
            } else {
            PG8_LDB(B0, 0, 0); PG8_SCHED; PG8_LDA(At, 0, 0); PG8_STAGE(PG8_SA(1, 1), a1 + hstep, voffA);
            PG8_WAIT_L(8); PG8_BAR; PG8_WAIT_L(0); PG8_MMA(0, 0, At, B0); PG8_BAR; PG8_SCHED;
            PG8_LDB(B1, 0, 1); PG8_STAGE(PG8_SB(0, 0), b2, voffB);
            PG8_BAR; PG8_WAIT_L(0); PG8_MMA(0, 1, At, B1); PG8_BAR;
            PG8_LDA(At, 0, 1); PG8_STAGE(PG8_SA(0, 0), a2, voffA);
            PG8_BAR; PG8_WAIT_L(0); PG8_MMA(1, 0, At, B0); PG8_BAR; PG8_SCHED;
            PG8_STAGE(PG8_SB(0, 1), b2 + hstep, voffB);
            PG8_WAIT_V(6); PG8_BAR; PG8_MMA(1, 1, At, B1); PG8_BAR;
            PG8_LDB(B0, 1, 0); PG8_SCHED; PG8_LDA(At, 1, 0); PG8_STAGE(PG8_SA(0, 1), a2 + hstep, voffA);
            PG8_WAIT_L(8); PG8_BAR; PG8_WAIT_L(0); PG8_MMA(0, 0, At, B0); PG8_BAR; PG8_SCHED;
            PG8_LDB(B1, 1, 1); PG8_STAGE(PG8_SB(1, 0), b3, voffB);
            PG8_BAR; PG8_WAIT_L(0); PG8_MMA(0, 1, At, B1); PG8_BAR;
            PG8_LDA(At, 1, 1); PG8_STAGE(PG8_SA(1, 0), a3, voffA);
            PG8_BAR; PG8_WAIT_L(0); PG8_MMA(1, 0, At, B0); PG8_BAR; PG8_SCHED;
            PG8_STAGE(PG8_SB(1, 1), b3 + hstep, voffB);
            PG8_WAIT_V(6); PG8_BAR; PG8_MMA(1, 1, At, B1); PG8_BAR;
            }
        }
        if constexpr (ALIGN_EPI) { if (wr == 0) PG8_BAR; }
        if constexpr (!Epi::AFTER_DRAIN) { E(acc, cur, wr, wc, fr, fq); S.done(cur); }
        if (!has_next) break;
#pragma unroll
        for (int a = 0; a < 2; ++a)
#pragma unroll
            for (int b = 0; b < 2; ++b)
#pragma unroll
                for (int m = 0; m < 4; ++m)
#pragma unroll
                    for (int n = 0; n < 2; ++n) acc[a][b][m][n] = (f32x4){0.f, 0.f, 0.f, 0.f};
        cur = nxt; cA = nA; cB = nB; ++ui;
        if constexpr (ALIGN_EPI) { if (wr == 1) PG8_BAR; }
    }
    PG8_WAIT_V(0);
    if constexpr (!ALIGN_EPI) { if (wr == 0) PG8_BAR; }
    PG8_BAR;
    if constexpr (Epi::AFTER_DRAIN) { E.fused(acc, cur, wr, wc, fr, fq, lds, wid, lane); S.done(cur); }
#undef PG8_SA
#undef PG8_SB
#undef PG8_STAGE
#undef PG8_LDA
#undef PG8_LDB
#undef PG8_MMA
#undef PG8_WAIT_V
#undef PG8_WAIT_L
#undef PG8_BAR
#undef PG8_SCHED
}
}

constexpr int NB = 4, SEQ = 4096, D = 1024, M = NB * SEQ, NIN = 1536, PW = 512, LW = 512, DFF = 2816, NGU = 2 * DFF;
constexpr float EPS = 1e-6f;
constexpr int MT = 2, CH = 16 * MT, NCHUNK = SEQ / CH, NT2 = NB * NCHUNK;
constexpr int NWAVES = 8;
constexpr int LDS_BYTES = 147456;

constexpr size_t KiB = 1024, MiB = 1u << 20;
constexpr size_t WS_SS2 = 0, WS_SS3 = 64 * KiB, WS_NSP = 128 * KiB;
constexpr size_t WS_POOLWT = 256 * KiB, WS_WAT = 384 * KiB, WS_WIT = 448 * KiB;
constexpr size_t WS_AGGA = 1 * MiB, WS_AGGB = 1 * MiB + 512 * KiB;
constexpr size_t WS_WIN = 2 * MiB, WS_WOUT = 5 * MiB, WS_WGU = 7 * MiB, WS_WD = 18 * MiB;
constexpr size_t WS_X1 = 24 * MiB;
constexpr size_t WS_X2 = 56 * MiB;
constexpr size_t WS_ACT = 104 * MiB;
constexpr size_t WS_END = 192 * MiB;
static_assert(WS_WD + (size_t)D * DFF * 2 <= WS_X1 && WS_X1 + (size_t)M * D * 2 <= WS_X2 && WS_X2 + (size_t)M * NIN * 2 <= WS_ACT && WS_ACT + (size_t)M * DFF * 2 <= WS_END, "d_ws map");

#define LAS __attribute__((address_space(3)))
typedef unsigned short bf16;
typedef float f32x4 __attribute__((ext_vector_type(4)));
typedef short bf16x8 __attribute__((ext_vector_type(8)));
typedef unsigned u32x4 __attribute__((ext_vector_type(4)));
typedef unsigned u32x2 __attribute__((ext_vector_type(2)));
#define LDS_WAIT() asm volatile("s_waitcnt lgkmcnt(0)" ::: "memory")

__device__ __forceinline__ unsigned pk2(float lo, float hi) { unsigned r; asm volatile("v_cvt_pk_bf16_f32 %0, %1, %2" : "=v"(r) : "v"(lo), "v"(hi)); return r; }
__device__ __forceinline__ f32x4 bf4_to_f32(u32x2 v) { f32x4 r; r[0] = __uint_as_float(v.x << 16); r[1] = __uint_as_float(v.x & 0xffff0000u); r[2] = __uint_as_float(v.y << 16); r[3] = __uint_as_float(v.y & 0xffff0000u); return r; }
__device__ __forceinline__ float wave_sum(float v) {
#pragma unroll
    for (int o = 1; o < 64; o <<= 1) v += __shfl_xor(v, o);
    return v;
}
template <int CTRL> __device__ __forceinline__ float dpp_f(float old, float src) { return __int_as_float(__builtin_amdgcn_update_dpp(__float_as_int(old), __float_as_int(src), CTRL, 0xf, 0xf, false)); }
__device__ __forceinline__ float sigmoidf_(float x) { return __builtin_amdgcn_rcpf(1.0f + __expf(-x)); }

__device__ __forceinline__ void tr_item(const float* W, int N, int k0, int n0, bf16* dst, int ldk, LAS float* scr, int lane) {
#pragma unroll 8
    for (int i = 0; i < 32; ++i) { const int kk = 2 * i + (lane >> 5); scr[kk * 33 + (lane & 31)] = W[(size_t)(k0 + kk) * N + n0 + (lane & 31)]; }
    LDS_WAIT();
    const int c = lane & 7;
#pragma unroll
    for (int j = 0; j < 4; ++j) { const int n = (lane >> 3) + 8 * j; const LAS float* s = scr + (8 * c) * 33 + n;
        u32x4 o; o.x = pk2(s[0 * 33], s[1 * 33]); o.y = pk2(s[2 * 33], s[3 * 33]); o.z = pk2(s[4 * 33], s[5 * 33]); o.w = pk2(s[6 * 33], s[7 * 33]);
        *(u32x4*)(dst + (size_t)n * ldk + 8 * c) = o; }
    LDS_WAIT();
}

struct Args { const float* in[20]; float* out; unsigned char* ws; };

__global__ void __launch_bounds__(NWAVES * 64, 2) fwd_kernel(Args args) {
    extern __shared__ __attribute__((aligned(16))) unsigned char lds_raw[];
    cg::grid_group grid = cg::this_grid();
    LAS unsigned char* lds = (LAS unsigned char*)lds_raw;
    const int tid = threadIdx.x, lane = tid & 63, wave = __builtin_amdgcn_readfirstlane(tid >> 6), fr_k = lane & 15, fq_k = lane >> 4, lane_k = lane;
    const int G = gridDim.x, bid = blockIdx.x, gw = bid * NWAVES + wave, NGW = G * NWAVES;
    unsigned char* ws = args.ws;
    const float* x = args.in[0]; const float* ln1_g = args.in[1]; const float* w_in = args.in[2]; const float* pool_w = args.in[3]; const float* pool_scale = args.in[4];
    const float* conv_w = args.in[5]; const float* conv_b = args.in[6]; const float* w_a = args.in[7]; const float* b_a = args.in[8]; const float* w_i = args.in[9]; const float* b_i = args.in[10];
    const float* lam = args.in[11]; const float* gn_pool_g = args.in[12]; const float* gn_lru_g = args.in[13]; const float* w_out = args.in[14]; const float* ln2_g = args.in[15];
    const float* w_gate = args.in[16]; const float* w_up = args.in[17]; const float* w_down = args.in[18]; const float* lnf_g = args.in[19];
    float* out = args.out;
    float* ss2 = (float*)(ws + WS_SS2); float* ss3 = (float*)(ws + WS_SS3); float* nsp = (float*)(ws + WS_NSP);
    bf16* poolwT = (bf16*)(ws + WS_POOLWT); bf16* waT = (bf16*)(ws + WS_WAT); bf16* wiT = (bf16*)(ws + WS_WIT);
    float* aggA = (float*)(ws + WS_AGGA); float* aggB = (float*)(ws + WS_AGGB);
    bf16* WinT = (bf16*)(ws + WS_WIN); bf16* WoutT = (bf16*)(ws + WS_WOUT); bf16* WguT = (bf16*)(ws + WS_WGU); bf16* WdT = (bf16*)(ws + WS_WD);
    bf16* xn = (bf16*)(ws + WS_X1); bf16* mix = (bf16*)(ws + WS_X1); bf16* proj = (bf16*)(ws + WS_X2); bf16* hb = (bf16*)(ws + WS_X2); bf16* act = (bf16*)(ws + WS_ACT);

    {
        for (int i = bid * 512 + tid; i < 2 * M; i += G * 512) ss2[i] = 0.f;
        if (bid == 0) nsp[tid] = -8.0f * log1pf(expf(-lam[tid]));
        LAS float* scr = (LAS float*)(lds + wave * 16384);
        constexpr int I_IN = (D / 64) * (NIN / 32), I_OUT = (D / 64) * (D / 32), I_G = (D / 64) * (DFF / 32), I_D = (DFF / 64) * (D / 32), I_P = 4 * 2 * 4, I_A = 8 * 2;
        constexpr int NITEMS = I_IN + I_OUT + 2 * I_G + I_D + I_P + 2 * I_A;
        for (int it = gw; it < NITEMS; it += NGW) {
            int r = it;
            if (r < I_IN) { const int kb = r / (NIN / 32), nb = r % (NIN / 32); tr_item(w_in, NIN, 64 * kb, 32 * nb, WinT + (size_t)(32 * nb) * D + 64 * kb, D, scr, lane); continue; } r -= I_IN;
            if (r < I_OUT) { const int kb = r / (D / 32), nb = r % (D / 32); tr_item(w_out, D, 64 * kb, 32 * nb, WoutT + (size_t)(32 * nb) * D + 64 * kb, D, scr, lane); continue; } r -= I_OUT;
            if (r < 2 * I_G) { const int up = r >= I_G ? 1 : 0; r -= up * I_G; const int kb = r / (DFF / 32), nb = r % (DFF / 32), n0 = 32 * nb, drow = 256 * (n0 / 128) + (n0 % 128) + 128 * up;
                tr_item(up ? w_up : w_gate, DFF, 64 * kb, n0, WguT + (size_t)drow * D + 64 * kb, D, scr, lane); continue; } r -= 2 * I_G;
            if (r < I_D) { const int kb = r / (D / 32), nb = r % (D / 32); tr_item(w_down, D, 64 * kb, 32 * nb, WdT + (size_t)(32 * nb) * DFF + 64 * kb, DFF, scr, lane); continue; } r -= I_D;
            if (r < I_P) { const int g = r / 8, kb = (r % 8) / 4, nb = r % 4; tr_item(pool_w + g * 16384, 128, 64 * kb, 32 * nb, poolwT + g * 16384 + (32 * nb) * 128 + 64 * kb, 128, scr, lane); continue; } r -= I_P;
            { const int wi = r >= I_A ? 1 : 0; r -= wi * I_A; const int h = r / 2, nb = r % 2; tr_item((wi ? w_i : w_a) + h * 4096, 64, 0, 32 * nb, (wi ? wiT : waT) + h * 4096 + (32 * nb) * 64, 64, scr, lane); }
        }
        f32x4 gv[4];
#pragma unroll
        for (int j = 0; j < 4; ++j) gv[j] = ((const f32x4*)ln1_g)[lane + 64 * j];
        for (int m = gw; m < M; m += NGW) {
            const f32x4* xr = (const f32x4*)(x + (size_t)m * D) + lane; f32x4 v[4]; float s = 0.f;
#pragma unroll
            for (int j = 0; j < 4; ++j) { v[j] = xr[64 * j]; s += (v[j].x * v[j].x + v[j].y * v[j].y) + (v[j].z * v[j].z + v[j].w * v[j].w); }
            const float rs = __builtin_amdgcn_rsqf(wave_sum(s) * (1.f / D) + EPS);
            u32x2* o8 = (u32x2*)(xn + (size_t)m * D) + lane;
#pragma unroll
            for (int j = 0; j < 4; ++j) { const f32x4 y = (v[j] * rs) * gv[j]; u32x2 w; w.x = pk2(y.x, y.y); w.y = pk2(y.z, y.w); o8[64 * j] = w; }
        }
    }
    grid.sync();

#if !defined(SKIP_P1)
    {
        pg8::Gemm g{xn, WinT, M, NIN, D}; pg8::StaticOrder S; S.init(M, NIN, G, bid);
        pg8::EpiStoreBf16 E{proj, NIN};
        pg8::gemm_phase<pg8::EpiStoreBf16, pg8::StaticOrder, true, true>(lds, g, S, E);
    }
    grid.sync();

#endif
#if !defined(SKIP_P2)
    {
        constexpr int PSTR = 1040;
        constexpr int XSTR = 144, XWAVE = CH * XSTR;
        constexpr int RED_OFF = 80 * 1024, RED2_OFF = 82 * 1024;
        LAS float* red = (LAS float*)(lds + RED_OFF); LAS float* red2 = (LAS float*)(lds + RED2_OFF);
        for (int base = 0; base < NT2; base += G) {
            const int tile = base + bid; const bool active = tile < NT2;
            const int bidx = tile / NCHUNK, cidx = tile % NCHUNK, t0 = cidx * CH; const size_t rowb = (size_t)bidx * SEQ;
            int fr = fr_k, fq = fq_k, lane = lane_k; asm volatile("" : "+v"(fr), "+v"(fq), "+v"(lane));
            const int h = wave, chl = h * 64 + 4 * fq;
            f32x4 xc[MT][4], av[MT][4];
            if (active) {
#if !defined(SKIP_POOL)
#pragma unroll
                for (int g = 0; g < 4; ++g) {
                    const int W = 2 << g;
#pragma unroll
                    for (int it = 0; it < MT / 2; ++it) {
                        const int tl = wave * (2 * MT) + it * 4 + (lane >> 4), cv = lane & 15, ch = g * 128 + cv * 8, pos = t0 + tl;
                        const bf16* p = proj + (rowb + pos) * NIN + ch;
                        const u32x4 c = *(const u32x4*)p;
                        float s[8], c8[8];
#pragma unroll
                        for (int e = 0; e < 4; ++e) { c8[2 * e] = __uint_as_float(c[e] << 16); c8[2 * e + 1] = __uint_as_float(c[e] & 0xffff0000u); s[2 * e] = c8[2 * e]; s[2 * e + 1] = c8[2 * e + 1]; }
#pragma unroll
                        for (int j = 1; j < W; ++j) { const int pj = pos - j; const float mk = pj >= 0 ? 1.f : 0.f; const u32x4 v = *(const u32x4*)(proj + (rowb + (pj >= 0 ? pj : 0)) * NIN + ch);
#pragma unroll
                            for (int e = 0; e < 4; ++e) { s[2 * e] += mk * __uint_as_float(v[e] << 16); s[2 * e + 1] += mk * __uint_as_float(v[e] & 0xffff0000u); } }
                        const float inv = 1.0f / (float)(pos + 1 < W ? pos + 1 : W);
                        u32x4 o;
#pragma unroll
                        for (int e = 0; e < 4; ++e) o[e] = pk2(s[2 * e] * inv - c8[2 * e], s[2 * e + 1] * inv - c8[2 * e + 1]);
                        *(LAS u32x4*)(lds + tl * PSTR + ch * 2) = o;
                    }
                }
                {
                    const int g = wave >> 1, nh = wave & 1, chp = g * 128 + nh * 64 + 4 * fq;
                    bf16x8 wf[4][4];
#pragma unroll
                    for (int n = 0; n < 4; ++n)
#pragma unroll
                        for (int ks = 0; ks < 4; ++ks) wf[n][ks] = *(const bf16x8*)(poolwT + (size_t)(g * 128 + nh * 64 + n * 16 + fr) * 128 + ks * 32 + fq * 8);
                    __syncthreads();
                    f32x4 acc[MT][4];
#pragma unroll
                    for (int m = 0; m < MT; ++m)
#pragma unroll
                        for (int n = 0; n < 4; ++n) acc[m][n] = (f32x4){0.f, 0.f, 0.f, 0.f};
#pragma unroll
                    for (int m = 0; m < MT; ++m)
#pragma unroll
                        for (int ks = 0; ks < 4; ++ks) { const bf16x8 xf = *(const LAS bf16x8*)(lds + (16 * m + fr) * PSTR + (g * 128 + ks * 32 + fq * 8) * 2);
#pragma unroll
                            for (int n = 0; n < 4; ++n) acc[m][n] = __builtin_amdgcn_mfma_f32_16x16x32_bf16(wf[n][ks], xf, acc[m][n], 0, 0, 0); }
                    f32x4 psc[4], pg[4];
#pragma unroll
                    for (int n = 0; n < 4; ++n) { psc[n] = *(const f32x4*)(pool_scale + chp + 16 * n); pg[n] = *(const f32x4*)(gn_pool_g + chp + 16 * n); }
#pragma unroll
                    for (int m = 0; m < MT; ++m) { float ss = 0.f;
#pragma unroll
                        for (int n = 0; n < 4; ++n) { acc[m][n] = acc[m][n] * psc[n]; const f32x4 y = acc[m][n]; ss += (y[0] * y[0] + y[1] * y[1]) + (y[2] * y[2] + y[3] * y[3]); }
                        ss += __shfl_xor(ss, 16); ss += __shfl_xor(ss, 32);
                        if (fq == 0) red[(16 * m + fr) * 8 + wave] = ss; }
                    __syncthreads();
#pragma unroll
                    for (int m = 0; m < MT; ++m) { const f32x4 r0 = *(const LAS f32x4*)(red + (16 * m + fr) * 8), r1 = *(const LAS f32x4*)(red + (16 * m + fr) * 8 + 4);
                        const float tot = ((r0[0] + r0[1]) + (r0[2] + r0[3])) + ((r1[0] + r1[1]) + (r1[2] + r1[3]));
                        const float rs = __builtin_amdgcn_rsqf(tot * (1.f / PW) + EPS);
                        bf16* mp = mix + (rowb + t0 + 16 * m + fr) * D + chp;
#pragma unroll
                        for (int n = 0; n < 4; ++n) { const f32x4 y = (acc[m][n] * rs) * pg[n]; u32x2 w; w.x = pk2(y[0], y[1]); w.y = pk2(y[2], y[3]); *(u32x2*)(mp + 16 * n) = w; } }
                }
#endif
                LAS unsigned char* lx = lds + wave * XWAVE;
#pragma unroll
                for (int n = 0; n < 4; ++n) {
                    const int chn = chl + 16 * n;
                    f32x4 cw[4];
#pragma unroll
                    for (int k = 0; k < 4; ++k) cw[k] = *(const f32x4*)(conv_w + k * LW + chn);
                    const f32x4 cb = *(const f32x4*)(conv_b + chn);
                    f32x4 u[MT + 3];
#pragma unroll
                    for (int r = 0; r < MT + 3; ++r) { const int pos = t0 + MT * fr - 3 + r; const u32x2 raw = *(const u32x2*)(proj + (rowb + (pos >= 0 ? pos : 0)) * NIN + PW + chn);
                        u[r] = bf4_to_f32(raw); if (pos < 0) u[r] = (f32x4){0.f, 0.f, 0.f, 0.f}; }
#pragma unroll
                    for (int m = 0; m < MT; ++m) { const f32x4 v = cb + cw[0] * u[m] + cw[1] * u[m + 1] + cw[2] * u[m + 2] + cw[3] * u[m + 3]; xc[m][n] = v;
                        u32x2 w; w.x = pk2(v[0], v[1]); w.y = pk2(v[2], v[3]); *(LAS u32x2*)(lx + (m * 16 + fr) * XSTR + (n * 16 + 4 * fq) * 2) = w; }
                }
                LDS_WAIT();
#pragma unroll
                for (int n = 0; n < 4; ++n) {
                    const int chn = chl + 16 * n;
                    bf16x8 waf[2], wif[2];
#pragma unroll
                    for (int ks = 0; ks < 2; ++ks) { waf[ks] = *(const bf16x8*)(waT + (size_t)(h * 64 + n * 16 + fr) * 64 + ks * 32 + fq * 8); wif[ks] = *(const bf16x8*)(wiT + (size_t)(h * 64 + n * 16 + fr) * 64 + ks * 32 + fq * 8); }
                    const f32x4 ba = *(const f32x4*)(b_a + chn), bi = *(const f32x4*)(b_i + chn), sp = *(const f32x4*)(nsp + chn);
#pragma unroll
                    for (int m = 0; m < MT; ++m) {
                            const bf16x8 xf0 = *(const LAS bf16x8*)(lx + (m * 16 + fr) * XSTR + (fq * 8) * 2), xf1 = *(const LAS bf16x8*)(lx + (m * 16 + fr) * XSTR + (32 + fq * 8) * 2);
                        f32x4 ra = (f32x4){0.f, 0.f, 0.f, 0.f}, ia = (f32x4){0.f, 0.f, 0.f, 0.f};
                        ra = __builtin_amdgcn_mfma_f32_16x16x32_bf16(waf[0], xf0, ra, 0, 0, 0); ra = __builtin_amdgcn_mfma_f32_16x16x32_bf16(waf[1], xf1, ra, 0, 0, 0);
                        ia = __builtin_amdgcn_mfma_f32_16x16x32_bf16(wif[0], xf0, ia, 0, 0, 0); ia = __builtin_amdgcn_mfma_f32_16x16x32_bf16(wif[1], xf1, ia, 0, 0, 0);
#pragma unroll
                        for (int j = 0; j < 4; ++j) { const float rr = sigmoidf_(ra[j] + ba[j]), ii = sigmoidf_(ia[j] + bi[j]); const float la = rr * sp[j];
                            const float a = __expf(la), x2 = 2.0f * la;
                            const float pl = -x2 * (1.0f + x2 * (0.5f + x2 * (0.16666667f + x2 * (0.041666668f + x2 * (0.0083333338f + x2 * (0.0013888889f + x2 * 0.0001984127f))))));
                            const float mult = __builtin_amdgcn_sqrtf(fmaxf(x2 > -0.25f ? pl : 1.0f - a * a, 0.0f));
                            av[m][n][j] = a; xc[m][n][j] = mult * ii * xc[m][n][j]; }
                    }
                }
#pragma unroll
                for (int n = 0; n < 4; ++n)
#pragma unroll
                    for (int j = 0; j < 4; ++j) {
#pragma unroll
                        for (int m = 1; m < MT; ++m) { xc[m][n][j] = av[m][n][j] * xc[m - 1][n][j] + xc[m][n][j]; av[m][n][j] = av[m][n][j] * av[m - 1][n][j]; }
                        float Pi = av[MT - 1][n][j], Hi = xc[MT - 1][n][j], ap, hp;
                        ap = dpp_f<0x111>(1.0f, Pi); hp = dpp_f<0x111>(0.0f, Hi); Hi = Pi * hp + Hi; Pi = Pi * ap;
                        ap = dpp_f<0x112>(1.0f, Pi); hp = dpp_f<0x112>(0.0f, Hi); Hi = Pi * hp + Hi; Pi = Pi * ap;
                        ap = dpp_f<0x114>(1.0f, Pi); hp = dpp_f<0x114>(0.0f, Hi); Hi = Pi * hp + Hi; Pi = Pi * ap;
                        ap = dpp_f<0x118>(1.0f, Pi); hp = dpp_f<0x118>(0.0f, Hi); Hi = Pi * hp + Hi; Pi = Pi * ap;
                        const float Pe = dpp_f<0x111>(1.0f, Pi), He = dpp_f<0x111>(0.0f, Hi);
#pragma unroll
                        for (int m = 0; m < MT; ++m) { xc[m][n][j] = xc[m][n][j] + av[m][n][j] * He; av[m][n][j] = av[m][n][j] * Pe; }
                    }
                if (fr == 15) {
#pragma unroll
                    for (int n = 0; n < 4; ++n) { *(f32x4*)(aggA + (size_t)tile * LW + chl + 16 * n) = av[MT - 1][n]; *(f32x4*)(aggB + (size_t)tile * LW + chl + 16 * n) = xc[MT - 1][n]; }
                }
            }
            grid.sync();
            if (active) {
                f32x4 carry[4];
#pragma unroll
                for (int n = 0; n < 4; ++n) carry[n] = (f32x4){0.f, 0.f, 0.f, 0.f};
#pragma unroll 2
                for (int jc = 0; jc < cidx; ++jc) { const size_t o = (size_t)(bidx * NCHUNK + jc) * LW + chl;
#pragma unroll
                    for (int n = 0; n < 4; ++n) { const f32x4 A = *(const f32x4*)(aggA + o + 16 * n), B = *(const f32x4*)(aggB + o + 16 * n); carry[n] = A * carry[n] + B; } }
                f32x4 gl[4];
#pragma unroll
                for (int n = 0; n < 4; ++n) gl[n] = *(const f32x4*)(gn_lru_g + chl + 16 * n);
#pragma unroll
                for (int m = 0; m < MT; ++m) { float ss = 0.f; const bf16* gp = proj + (rowb + t0 + MT * fr + m) * NIN + PW + LW + chl;
#pragma unroll
                    for (int n = 0; n < 4; ++n) { const f32x4 hh = xc[m][n] + av[m][n] * carry[n]; const f32x4 gt = bf4_to_f32(*(const u32x2*)(gp + 16 * n)); f32x4 y;
#pragma unroll
                        for (int j = 0; j < 4; ++j) { const float z = gt[j]; y[j] = hh[j] * z * sigmoidf_(1.5957691216f * (z + 0.044715f * z * z * z)); }
                        xc[m][n] = y; ss += (y[0] * y[0] + y[1] * y[1]) + (y[2] * y[2] + y[3] * y[3]); }
                    ss += __shfl_xor(ss, 16); ss += __shfl_xor(ss, 32);
                    if (fq == 0) red2[(MT * fr + m) * 8 + wave] = ss; }
                __syncthreads();
#pragma unroll
                for (int m = 0; m < MT; ++m) { const f32x4 r0 = *(const LAS f32x4*)(red2 + (MT * fr + m) * 8), r1 = *(const LAS f32x4*)(red2 + (MT * fr + m) * 8 + 4);
                    const float tot = ((r0[0] + r0[1]) + (r0[2] + r0[3])) + ((r1[0] + r1[1]) + (r1[2] + r1[3]));
                    const float rs = __builtin_amdgcn_rsqf(tot * (1.f / LW) + EPS);
                    bf16* mp = mix + (rowb + t0 + MT * fr + m) * D + PW + chl;
#pragma unroll
                    for (int n = 0; n < 4; ++n) { const f32x4 y = (xc[m][n] * rs) * gl[n]; u32x2 w; w.x = pk2(y[0], y[1]); w.y = pk2(y[2], y[3]); *(u32x2*)(mp + 16 * n) = w; } }
                __syncthreads();
            }
        }
    }
    grid.sync();

#endif
#if !defined(SKIP_P3)
    {
        pg8::Gemm g{mix, WoutT, M, D, D}; pg8::StaticOrder S; S.init(M, D, G, bid);
        pg8::EpiResid<true> E{x, out, hb, ln2_g, ss2, D};
        pg8::gemm_phase<pg8::EpiResid<true>, pg8::StaticOrder, true, true>(lds, g, S, E);
    }
    grid.sync();

#endif
#if !defined(SKIP_P4)
    {
        pg8::Gemm g{hb, WguT, M, NGU, D}; pg8::StaticOrder S; S.init(M, NGU, G, bid);
        pg8::EpiSwiGLU E{act, DFF, ss2, 1.f / D, EPS};
        pg8::gemm_phase<pg8::EpiSwiGLU, pg8::StaticOrder, true, true>(lds, g, S, E);
    }
    grid.sync();

#endif
#if !defined(SKIP_P5)
    {
        pg8::Gemm g{act, WdT, M, D, DFF}; pg8::StaticOrder S; S.init(M, D, G, bid);
        pg8::EpiResid<false> E{out, out, nullptr, nullptr, ss3, D};
        pg8::gemm_phase<pg8::EpiResid<false>, pg8::StaticOrder, true, true>(lds, g, S, E);
    }
    grid.sync();

#endif
    {
        f32x4 gv[4];
#pragma unroll
        for (int j = 0; j < 4; ++j) gv[j] = ((const f32x4*)lnf_g)[lane + 64 * j];
        for (int m = gw; m < M; m += NGW) {
            f32x4* xr = (f32x4*)(out + (size_t)m * D) + lane;
            const float rs = __builtin_amdgcn_rsqf(ss3[m] * (1.f / D) + EPS);
#pragma unroll
            for (int j = 0; j < 4; ++j) { const f32x4 v = xr[64 * j]; xr[64 * j] = (v * rs) * gv[j]; }
        }
    }
}

extern "C" void kernel_launch(void* const* d_in, const int* in_sizes, int n_in, void* d_out, int out_size, void* d_ws, size_t ws_size, hipStream_t stream) {
    static int grid = 0;
    if (grid == 0) {
        if (n_in != 20 || in_sizes[0] != M * D || out_size != M * D || ws_size < WS_END) { fprintf(stderr, "kernel_launch: unexpected shapes (n_in %d, in0 %d, out %d, ws %zu)\n", n_in, n_in > 0 ? in_sizes[0] : -1, out_size, ws_size); grid = -1; return; }
        int dev = 0, cus = 0, per_cu = 0;
        (void)hipGetDevice(&dev); (void)hipDeviceGetAttribute(&cus, hipDeviceAttributeMultiprocessorCount, dev);
        if (hipFuncSetAttribute((const void*)fwd_kernel, hipFuncAttributeMaxDynamicSharedMemorySize, LDS_BYTES) != hipSuccess) { fprintf(stderr, "kernel_launch: hipFuncSetAttribute failed\n"); grid = -1; return; }
        if (hipOccupancyMaxActiveBlocksPerMultiprocessor(&per_cu, (const void*)fwd_kernel, NWAVES * 64, LDS_BYTES) != hipSuccess || per_cu < 1) per_cu = 1;
        (void)hipGetLastError();
        if (cus < 1) cus = 256;
        grid = cus * per_cu;
    }
    if (grid < 0) return;
    Args a{};
    for (int i = 0; i < 20; ++i) a.in[i] = (const float*)d_in[i];
    a.out = (float*)d_out; a.ws = (unsigned char*)d_ws;
    void* kargs[] = {&a};
    hipError_t e = hipLaunchCooperativeKernel((const void*)fwd_kernel, dim3(grid), dim3(NWAVES * 64), kargs, LDS_BYTES, stream);
    if (e != hipSuccess) fprintf(stderr, "kernel_launch: cooperative launch failed: %s (grid %d)\n", hipGetErrorString(e), grid);
}
```

```cpp
#include <hip/hip_runtime.h>
#include <hip/hip_cooperative_groups.h>
#include <cstdio>
#include <cstdint>
namespace cg = cooperative_groups;
namespace pg8 {
#define PG8_LAS __attribute__((address_space(3)))
typedef unsigned short bf16_t;
typedef short bf16x8 __attribute__((ext_vector_type(8)));
typedef float f32x4 __attribute__((ext_vector_type(4)));
typedef unsigned u32x4 __attribute__((ext_vector_type(4)));
constexpr int BM = 256, BK = 64, HALF = 128, HTB = HALF * BK * 2  , STAGE_BYTES = 8 * HTB, NXCD = 8, WGM = 8;

__host__ __device__ __forceinline__ int lds_byte(int r, int c) { const int st = (r >> 4) * 2 + (c >> 5), rr = r & 15, cc = c & 31, ob = rr * 64 + cc * 2; return st * 1024 + (ob ^ (((ob >> 9) & 1) << 5)); }
__host__ __device__ __forceinline__ void stage_rc(int b, int& R, int& C) { const int st = b / 1024, sb = b % 1024, swz = sb ^ (((sb >> 9) & 1) << 5); R = (st >> 1) * 16 + swz / 64; C = (st & 1) * 32 + (swz % 64) / 2; }
__host__ __device__ __forceinline__ int perm32(int rho) { const int n = rho >> 4, i = rho & 15; return 8 * (i >> 2) + 4 * n + (i & 3); }

struct Unit { int pm, pn; };
struct Gemm { const bf16_t* A; const bf16_t* Bt; int M, N, K; };

struct StaticOrder {
    int nM, nN, nwg, G, c;
    __host__ __device__ void init(int M, int N, int G_, int c_) { nM = M / BM; nN = N / BM; nwg = nM * nN; G = G_; c = c_; }
    __host__ __device__ bool next(int i, Unit& u) const {
        const long L = (long)i * G + c; if (L >= nwg) return false;
        int wgid = (int)L; { const int q = nwg / NXCD, r = nwg % NXCD, xcd = wgid % NXCD, off = wgid / NXCD; wgid = (xcd < r ? xcd * (q + 1) : r * (q + 1) + (xcd - r) * q) + off; }
        const int nig = WGM * nN, gid = wgid / nig, fm = gid * WGM, gsz = (nM - fm) < WGM ? (nM - fm) : WGM;
        u.pm = fm + ((wgid % nig) % gsz); u.pn = (wgid % nig) / gsz; return true;
    }
    __device__ __forceinline__ void a_ready(const Unit&) const {}
    __device__ __forceinline__ void done(const Unit&) const {}
};

__device__ __forceinline__ unsigned cvt_pk_bf16(float lo, float hi) { unsigned r; asm volatile("v_cvt_pk_bf16_f32 %0, %1, %2" : "=v"(r) : "v"(lo), "v"(hi)); return r; }
typedef unsigned u32x2 __attribute__((ext_vector_type(2)));
struct EpiStoreBf16 {
    static constexpr bool PERM = true, AFTER_DRAIN = false;
    bf16_t* O; int ldc;
    __device__ __forceinline__ void operator()(const f32x4 (&acc)[2][2][4][2], const Unit& u, int wr, int wc, int fr, int fq) const {
        const int row0 = u.pm * BM + wr * 64 + fr, col0 = u.pn * BM + wc * 32 + 8 * fq;
#pragma unroll
        for (int ai = 0; ai < 2; ++ai)
#pragma unroll
            for (int m = 0; m < 4; ++m) { bf16_t* rowp = O + (size_t)(row0 + ai * HALF + m * 16) * ldc + col0;
#pragma unroll
                for (int bj = 0; bj < 2; ++bj) { const f32x4 v0 = acc[ai][bj][m][0], v1 = acc[ai][bj][m][1];
                    u32x4 w; w.x = cvt_pk_bf16(v0[0], v0[1]); w.y = cvt_pk_bf16(v0[2], v0[3]); w.z = cvt_pk_bf16(v1[0], v1[1]); w.w = cvt_pk_bf16(v1[2], v1[3]);
                    *(u32x4*)(rowp + bj * HALF) = w; } }
    }
};
struct EpiSwiGLU {
    static constexpr bool PERM = true, AFTER_DRAIN = false;
    bf16_t* O; int ldo; const float* sumsq; float inv_n, eps;
    __device__ __forceinline__ void operator()(const f32x4 (&acc)[2][2][4][2], const Unit& u, int wr, int wc, int fr, int fq) const {
        const int row0 = u.pm * BM + wr * 64 + fr, col0 = u.pn * HALF + wc * 32 + 8 * fq;
#pragma unroll
        for (int ai = 0; ai < 2; ++ai)
#pragma unroll
            for (int m = 0; m < 4; ++m) { const int row = row0 + ai * HALF + m * 16;
                const float rs = __builtin_amdgcn_rsqf(sumsq[row] * inv_n + eps);
                float o[8];
#pragma unroll
                for (int n = 0; n < 2; ++n)
#pragma unroll
                    for (int j = 0; j < 4; ++j) { const float g = acc[ai][0][m][n][j] * rs, up = acc[ai][1][m][n][j] * rs;
                        o[n * 4 + j] = g * __builtin_amdgcn_rcpf(1.0f + __expf(-g)) * up; }
                u32x4 w; w.x = cvt_pk_bf16(o[0], o[1]); w.y = cvt_pk_bf16(o[2], o[3]); w.z = cvt_pk_bf16(o[4], o[5]); w.w = cvt_pk_bf16(o[6], o[7]);
                *(u32x4*)(O + (size_t)row * ldo + col0) = w; }
    }
};
template <bool WITH_HB> struct EpiResid {
    static constexpr bool PERM = false, AFTER_DRAIN = false;
    const float* base; float* out; bf16_t* hb; const float* g; float* sumsq; int ldc;
    __device__ __forceinline__ void operator()(const f32x4 (&acc)[2][2][4][2], const Unit& u, int wr, int wc, int fr, int fq) const {
        const int col0 = u.pn * BM + wc * 32 + 4 * fq;
        f32x4 gv[2][2];
        if (WITH_HB) {
#pragma unroll
            for (int bj = 0; bj < 2; ++bj)
#pragma unroll
                for (int n = 0; n < 2; ++n) gv[bj][n] = *(const f32x4*)(g + col0 + bj * HALF + n * 16);
        }
#pragma unroll
        for (int ai = 0; ai < 2; ++ai)
#pragma unroll
            for (int m = 0; m < 4; ++m) { const int r = u.pm * BM + ai * HALF + wr * 64 + m * 16 + fr; const size_t off = (size_t)r * ldc + col0; float ss = 0.f;
#pragma unroll
                for (int bj = 0; bj < 2; ++bj)
#pragma unroll
                    for (int n = 0; n < 2; ++n) { const f32x4 bs = *(const f32x4*)(base + off + bj * HALF + n * 16); const f32x4 h = bs + acc[ai][bj][m][n];
                        *(f32x4*)(out + off + bj * HALF + n * 16) = h; ss += (h[0] * h[0] + h[1] * h[1]) + (h[2] * h[2] + h[3] * h[3]);
                        if (WITH_HB) { const f32x4 hg = h * gv[bj][n]; u32x2 w; w.x = cvt_pk_bf16(hg[0], hg[1]); w.y = cvt_pk_bf16(hg[2], hg[3]); *(u32x2*)(hb + off + bj * HALF + n * 16) = w; } }
                ss += __shfl_xor(ss, 16); ss += __shfl_xor(ss, 32);
                if (fq == 0) atomicAdd(sumsq + r, ss);
                if (m & 1) asm volatile("" ::: "memory"); }
    }
};
template <class Epi, class Sched, bool ALIGN_EPI = false, bool SP2 = false>
__device__ __forceinline__ void gemm_phase(PG8_LAS unsigned char* lds, const Gemm g, const Sched& S, const Epi& E) {
    const int tid = threadIdx.x, wid = __builtin_amdgcn_readfirstlane(tid >> 6), lane = tid & 63, wr = wid >> 2, wc = wid & 3, fr = lane & 15, fq = lane >> 4;
    const int K = g.K, nt = K / BK;
    unsigned voffA[2], voffB[2];
#pragma unroll
    for (int i = 0; i < 2; ++i) { int R, C; stage_rc(tid * 16 + i * 8192, R, C); const int Rb = Epi::PERM ? ((R & ~31) + perm32(R & 31)) : R;
        voffA[i] = (unsigned)(R * K + C) * 2u; voffB[i] = (unsigned)(Rb * K + C) * 2u; }
    const size_t kstep = (size_t)(BK * 2);
    const size_t hstep = (size_t)HALF * K * 2;
    const size_t tstep = 2 * hstep;
    const unsigned ldsw = (unsigned)wid * 1024u;
    const int aoff = lds_byte(wr * 64 + fr, fq * 8), boff = lds_byte(wc * 32 + fr, fq * 8);
#define PG8_SA(b, h) (((b) * 2 + (h)) * HTB)
#define PG8_SB(b, h) ((4 + (b) * 2 + (h)) * HTB)
#define PG8_STAGE(bufoff, gbase, voff) do { _Pragma("unroll") for (int _i = 0; _i < 2; ++_i) \
        __builtin_amdgcn_global_load_lds((const unsigned*)((const char*)(gbase) + (voff)[_i]), (PG8_LAS unsigned*)(lds + (bufoff) + ldsw + _i * 8192), 16, 0, 0); } while (0)
#define PG8_LDA(dst, b, h) do { _Pragma("unroll") for (int m = 0; m < 4; ++m) _Pragma("unroll") for (int k = 0; k < 2; ++k) dst[m][k] = *(const PG8_LAS bf16x8*)(lds + PG8_SA(b, h) + aoff + m * 2048 + k * 1024); } while (0)
#define PG8_LDB(dst, b, h) do { _Pragma("unroll") for (int n = 0; n < 2; ++n) _Pragma("unroll") for (int k = 0; k < 2; ++k) dst[n][k] = *(const PG8_LAS bf16x8*)(lds + PG8_SB(b, h) + boff + n * 2048 + k * 1024); } while (0)
#define PG8_MMA(ai, bj, At, Bt) do { __builtin_amdgcn_s_setprio(1); _Pragma("unroll") for (int m = 0; m < 4; ++m) _Pragma("unroll") for (int n = 0; n < 2; ++n) _Pragma("unroll") for (int k = 0; k < 2; ++k) \
        acc[ai][bj][m][n] = __builtin_amdgcn_mfma_f32_16x16x32_bf16(Bt[n][k], At[m][k], acc[ai][bj][m][n], 0, 0, 0); __builtin_amdgcn_s_setprio(0); } while (0)
#define PG8_WAIT_V(n) asm volatile("s_waitcnt vmcnt(" #n ")" ::: "memory")
#define PG8_WAIT_L(n) asm volatile("s_waitcnt lgkmcnt(" #n ")" ::: "memory")
#define PG8_BAR __builtin_amdgcn_s_barrier()
#define PG8_SCHED __builtin_amdgcn_sched_barrier(0)
    Unit cur, nxt; int ui = 0;
    if (!S.next(0, cur)) return;
    f32x4 acc[2][2][4][2];
#pragma unroll
    for (int a = 0; a < 2; ++a)
#pragma unroll
        for (int b = 0; b < 2; ++b)
#pragma unroll
            for (int m = 0; m < 4; ++m)
#pragma unroll
                for (int n = 0; n < 2; ++n) acc[a][b][m][n] = (f32x4){0.f, 0.f, 0.f, 0.f};
    bf16x8 At[4][2], B0[2][2], B1[2][2];
    const char* cA = (const char*)g.A + (size_t)cur.pm * tstep; const char* cB = (const char*)g.Bt + (size_t)cur.pn * tstep;
    S.a_ready(cur);
    if constexpr (SP2) {
        PG8_STAGE(PG8_SB(0, 0), cB, voffB); PG8_STAGE(PG8_SB(0, 1), cB + hstep, voffB); PG8_STAGE(PG8_SA(0, 0), cA, voffA); PG8_STAGE(PG8_SA(0, 1), cA + hstep, voffA);
        if (wr == 1) PG8_BAR;
        PG8_WAIT_V(2); PG8_BAR;
        PG8_STAGE(PG8_SB(1, 0), cB + kstep, voffB); PG8_STAGE(PG8_SA(1, 0), cA + kstep, voffA); PG8_STAGE(PG8_SB(1, 1), cB + hstep + kstep, voffB);
        PG8_WAIT_V(6); PG8_BAR;
    } else {
        PG8_STAGE(PG8_SB(0, 0), cB, voffB); PG8_STAGE(PG8_SA(0, 0), cA, voffA); PG8_STAGE(PG8_SB(0, 1), cB + hstep, voffB); PG8_STAGE(PG8_SA(0, 1), cA + hstep, voffA);
        if (wr == 1) PG8_BAR;
        PG8_WAIT_V(4); PG8_BAR;
        PG8_STAGE(PG8_SB(1, 0), cB + kstep, voffB); PG8_STAGE(PG8_SA(1, 0), cA + kstep, voffA); PG8_STAGE(PG8_SB(1, 1), cB + hstep + kstep, voffB);
        PG8_WAIT_V(6); PG8_BAR;
    }
    for (;;) {
        const bool has_next = S.next(ui + 1, nxt);
        const char* nA = has_next ? (const char*)g.A + (size_t)nxt.pm * tstep : cA; const char* nB = has_next ? (const char*)g.Bt + (size_t)nxt.pn * tstep : cB;
        for (int t = 0; t < nt; t += 2) {
            const bool last = (t == nt - 2);
            const char* a1 = cA + (size_t)(t + 1) * kstep;
            const char* a2 = last ? nA : cA + (size_t)(t + 2) * kstep; const char* b2 = last ? nB : cB + (size_t)(t + 2) * kstep;
            const char* a3 = a2 + kstep; const char* b3 = b2 + kstep;
            if (last && has_next) S.a_ready(nxt);
            if constexpr (SP2) {
            PG8_LDB(B0, 0, 0); PG8_LDB(B1, 0, 1); PG8_SCHED; PG8_LDA(At, 0, 0); PG8_STAGE(PG8_SA(1, 1), a1 + hstep, voffA);
            PG8_WAIT_V(8); PG8_WAIT_L(0); PG8_BAR; PG8_MMA(0, 0, At, B0); PG8_MMA(0, 1, At, B1); PG8_BAR; PG8_SCHED;
            PG8_LDA(At, 0, 1); PG8_STAGE(PG8_SB(0, 0), b2, voffB); PG8_STAGE(PG8_SB(0, 1), b2 + hstep, voffB); PG8_STAGE(PG8_SA(0, 0), a2, voffA);
            PG8_WAIT_V(8); PG8_WAIT_L(0); PG8_BAR; PG8_MMA(1, 0, At, B0); PG8_MMA(1, 1, At, B1); PG8_BAR; PG8_SCHED;
            PG8_LDB(B0, 1, 0); PG8_LDB(B1, 1, 1); PG8_SCHED; PG8_LDA(At, 1, 0); PG8_STAGE(PG8_SA(0, 1), a2 + hstep, voffA);
            PG8_WAIT_V(8); PG8_WAIT_L(0); PG8_BAR; PG8_MMA(0, 0, At, B0); PG8_MMA(0, 1, At, B1); PG8_BAR; PG8_SCHED;
            PG8_LDA(At, 1, 1); PG8_STAGE(PG8_SB(1, 0), b3, voffB); PG8_STAGE(PG8_SB(1, 1), b3 + hstep, voffB); PG8_STAGE(PG8_SA(1, 0), a3, voffA);
            PG8_WAIT_V(8); PG8_WAIT_L(0); PG8_BAR; PG8_MMA(1, 0, At, B0); PG8_MMA(1, 1, At, B1); PG8_BAR; PG8_SCHED;
            } else {
            PG8_LDB(B0, 0, 0); PG8_SCHED; PG8_LDA(At, 0, 0); PG8_STAGE(PG8_SA(1, 1), a1 + hstep, voffA);
            PG8_WAIT_L(8); PG8_BAR; PG8_WAIT_L(0); PG8_MMA(0, 0, At, B0); PG8_BAR; PG8_SCHED;
            PG8_LDB(B1, 0, 1); PG8_STAGE(PG8_SB(0, 0), b2, voffB);
            PG8_BAR; PG8_WAIT_L(0); PG8_MMA(0, 1, At, B1); PG8_BAR;
            PG8_LDA(At, 0, 1); PG8_STAGE(PG8_SA(0, 0), a2, voffA);
            PG8_BAR; PG8_WAIT_L(0); PG8_MMA(1, 0, At, B0); PG8_BAR; PG8_SCHED;
            PG8_STAGE(PG8_SB(0, 1), b2 + hstep, voffB);
            PG8_WAIT_V(6); PG8_BAR; PG8_MMA(1, 1, At, B1); PG8_BAR;
            PG8_LDB(B0, 1, 0); PG8_SCHED; PG8_LDA(At, 1, 0); PG8_STAGE(PG8_SA(0, 1), a2 + hstep, voffA);
            PG8_WAIT_L(8); PG8_BAR; PG8_WAIT_L(0); PG8_MMA(0, 0, At, B0); PG8_BAR; PG8_SCHED;
            PG8_LDB(B1, 1, 1); PG8_STAGE(PG8_SB(1, 0), b3, voffB);
            PG8_BAR; PG8_WAIT_L(0); PG8_MMA(0, 1, At, B1); PG8_BAR;
            PG8_LDA(At, 1, 1); PG8_STAGE(PG8_SA(1, 0), a3, voffA);
            PG8_BAR; PG8_WAIT_L(0); PG8_MMA(1, 0, At, B0); PG8_BAR; PG8_SCHED;
            PG8_STAGE(PG8_SB(1, 1), b3 + hstep, voffB);
            PG8_WAIT_V(6); PG8_BAR; PG8_MMA(1, 1, At, B1); PG8_BAR;
            }
        }
        if constexpr (ALIGN_EPI) { if (wr == 0) PG8_BAR; }
        if constexpr (!Epi::AFTER_DRAIN) { E(acc, cur, wr, wc, fr, fq); S.done(cur); }
        if (!has_next) break;
#pragma unroll
        for (int a = 0; a < 2; ++a)
#pragma unroll
            for (int b = 0; b < 2; ++b)
#pragma unroll
                for (int m = 0; m < 4; ++m)
#pragma unroll
                    for (int n = 0; n < 2; ++n) acc[a][b][m][n] = (f32x4){0.f, 0.f, 0.f, 0.f};
        cur = nxt; cA = nA; cB = nB; ++ui;
        if constexpr (ALIGN_EPI) { if (wr == 1) PG8_BAR; }
    }
    PG8_WAIT_V(0);
    if constexpr (!ALIGN_EPI) { if (wr == 0) PG8_BAR; }
    PG8_BAR;
    if constexpr (Epi::AFTER_DRAIN) { E.fused(acc, cur, wr, wc, fr, fq, lds, wid, lane); S.done(cur); }
#undef PG8_SA
#undef PG8_SB
#undef PG8_STAGE
#undef PG8_LDA
#undef PG8_LDB
#undef PG8_MMA
#undef PG8_WAIT_V
#undef PG8_WAIT_L
#undef PG8_BAR
#undef PG8_SCHED
}
}

constexpr int NB = 4, SEQ = 4096, D = 1024, M = NB * SEQ, NIN = 1536, PW = 512, LW = 512, DFF = 2816, NGU = 2 * DFF;
constexpr float EPS = 1e-6f;
constexpr int MT = 2, CH = 16 * MT, NCHUNK = SEQ / CH, NT2 = NB * NCHUNK;
constexpr int NWAVES = 8;
constexpr int LDS_BYTES = 147456;

constexpr size_t KiB = 1024, MiB = 1u << 20;
constexpr size_t WS_SS2 = 0, WS_SS3 = 64 * KiB, WS_NSP = 128 * KiB;
constexpr size_t WS_BAR = 192 * KiB, BAR_BYTES = 16 * KiB;
constexpr size_t WS_POOLWT = 256 * KiB, WS_WAT = 384 * KiB, WS_WIT = 448 * KiB;
constexpr size_t WS_AGGA = 1 * MiB, WS_AGGB = 1 * MiB + 512 * KiB;
constexpr size_t WS_WIN = 2 * MiB, WS_WOUT = 5 * MiB, WS_WGU = 7 * MiB, WS_WD = 18 * MiB;
constexpr size_t WS_X1 = 24 * MiB;
constexpr size_t WS_X2 = 56 * MiB;
constexpr size_t WS_ACT = 104 * MiB;
constexpr size_t WS_END = 192 * MiB;
static_assert(WS_WD + (size_t)D * DFF * 2 <= WS_X1 && WS_X1 + (size_t)M * D * 2 <= WS_X2 && WS_X2 + (size_t)M * NIN * 2 <= WS_ACT && WS_ACT + (size_t)M * DFF * 2 <= WS_END, "d_ws map");

#define LAS __attribute__((address_space(3)))
typedef unsigned short bf16;
typedef float f32x4 __attribute__((ext_vector_type(4)));
typedef short bf16x8 __attribute__((ext_vector_type(8)));
typedef unsigned u32x4 __attribute__((ext_vector_type(4)));
typedef unsigned u32x2 __attribute__((ext_vector_type(2)));
#define LDS_WAIT() asm volatile("s_waitcnt lgkmcnt(0)" ::: "memory")

__device__ __forceinline__ unsigned pk2(float lo, float hi) { unsigned r; asm volatile("v_cvt_pk_bf16_f32 %0, %1, %2" : "=v"(r) : "v"(lo), "v"(hi)); return r; }
__device__ __forceinline__ f32x4 bf4_to_f32(u32x2 v) { f32x4 r; r[0] = __uint_as_float(v.x << 16); r[1] = __uint_as_float(v.x & 0xffff0000u); r[2] = __uint_as_float(v.y << 16); r[3] = __uint_as_float(v.y & 0xffff0000u); return r; }
__device__ __forceinline__ float wave_sum(float v) {
#pragma unroll
    for (int o = 1; o < 64; o <<= 1) v += __shfl_xor(v, o);
    return v;
}
template <int CTRL> __device__ __forceinline__ float dpp_f(float old, float src) { return __int_as_float(__builtin_amdgcn_update_dpp(__float_as_int(old), __float_as_int(src), CTRL, 0xf, 0xf, false)); }
__device__ __forceinline__ float sigmoidf_(float x) { return __builtin_amdgcn_rcpf(1.0f + __expf(-x)); }

__device__ __forceinline__ void tr_item(const float* W, int N, int k0, int n0, bf16* dst, int ldk, LAS float* scr, int lane) {
#pragma unroll 8
    for (int i = 0; i < 32; ++i) { const int kk = 2 * i + (lane >> 5); scr[kk * 33 + (lane & 31)] = W[(size_t)(k0 + kk) * N + n0 + (lane & 31)]; }
    LDS_WAIT();
    const int c = lane & 7;
#pragma unroll
    for (int j = 0; j < 4; ++j) { const int n = (lane >> 3) + 8 * j; const LAS float* s = scr + (8 * c) * 33 + n;
        u32x4 o; o.x = pk2(s[0 * 33], s[1 * 33]); o.y = pk2(s[2 * 33], s[3 * 33]); o.z = pk2(s[4 * 33], s[5 * 33]); o.w = pk2(s[6 * 33], s[7 * 33]);
        *(u32x4*)(dst + (size_t)n * ldk + 8 * c) = o; }
    LDS_WAIT();
}

#define XB_TMO      128
#define XB_XCNT(j)  (256  + 64 * (j))
#define XB_XSUB(j)  (1280 + 64 * (j))
#define XB_XGEN(j)  (2304 + 64 * (j))
#define XB_TOP      3328
#define XB_TOPGEN   3392
#define XCD_BAR_WORDS 3456
#define XB_SPIN_CAP (1u << 18)

__device__ __forceinline__ unsigned xb_ld(unsigned* p)              { return __hip_atomic_load(p, __ATOMIC_RELAXED, __HIP_MEMORY_SCOPE_AGENT); }
__device__ __forceinline__ unsigned xb_add(unsigned* p, unsigned v) { return __hip_atomic_fetch_add(p, v, __ATOMIC_RELAXED, __HIP_MEMORY_SCOPE_AGENT); }
__device__ __forceinline__ unsigned xb_xcc_id() { return (unsigned)__builtin_amdgcn_s_getreg((3 << 11) | 20) & 0xFu; }
#define XB_SPIN(cond, bar) do { unsigned _sp = 0; while (cond) { __builtin_amdgcn_s_sleep(1); \
    if ((++_sp & 255u) == 0u) { if (xb_ld(&(bar)[XB_TMO])) break; if (_sp > XB_SPIN_CAP) { atomicAdd(&(bar)[XB_TMO], 1u); break; } } } } while (0)

struct XcdBarrier {
    unsigned* bar; unsigned x;
    volatile LAS unsigned* st;
};

__device__ __forceinline__ XcdBarrier xcd_barrier_post(unsigned* bar, volatile LAS unsigned* st) {
    XcdBarrier b; b.bar = bar; b.x = xb_xcc_id(); b.st = st;
    if (threadIdx.x == 0) (void)xb_add(&bar[XB_XCNT(b.x)], 1u);
    return b;
}
__device__ __forceinline__ void xcd_barrier_complete(unsigned* bar, unsigned x, unsigned& nloc, unsigned& nx) {
    const unsigned G = gridDim.x * gridDim.y * gridDim.z;
    unsigned sum, cnt, mine, sp = 0u;
    for (;;) {
        sum = 0u; cnt = 0u; mine = 0u;
#pragma unroll
        for (unsigned j = 0; j < 16; ++j) { const unsigned c = xb_ld(&bar[XB_XCNT(j)]); sum += c; cnt += (c > 0u) ? 1u : 0u; mine = (j == x) ? c : mine; }
        if (sum == G) break;
        __builtin_amdgcn_s_sleep(1);
        if ((++sp & 255u) == 0u) { if (xb_ld(&bar[XB_TMO])) break; if (sp > XB_SPIN_CAP) { atomicAdd(&bar[XB_TMO], 1u); break; } }
    }
    nloc = mine > 0u ? mine : 1u; nx = cnt > 0u ? cnt : 1u;
}

__device__ __forceinline__ void xcd_barrier(const XcdBarrier& b) {
    asm volatile("s_waitcnt vmcnt(0)" ::: "memory");
    __syncthreads();
    if (threadIdx.x == 0) {
        unsigned* bar = b.bar;
        __builtin_amdgcn_s_waitcnt(0);
        unsigned nloc = b.st[0], nx = b.st[1];
        if (nloc == 0u) { xcd_barrier_complete(bar, b.x, nloc, nx); b.st[0] = nloc; b.st[1] = nx; }
        const unsigned old = xb_add(&bar[XB_XSUB(b.x)], 1u);
        const unsigned gen = old / nloc;
        if (old + 1u == (gen + 1u) * nloc) {
            __builtin_amdgcn_fence(__ATOMIC_RELEASE, "agent");
            asm volatile("s_waitcnt vmcnt(0)" ::: "memory");
            const unsigned og = xb_add(&bar[XB_TOP], 1u);
            const unsigned tg = og / nx;
            if (og + 1u == (tg + 1u) * nx) xb_add(&bar[XB_TOPGEN], 1u);
            else XB_SPIN(xb_ld(&bar[XB_TOPGEN]) == tg, bar);
            __builtin_amdgcn_fence(__ATOMIC_ACQUIRE, "agent");
            xb_add(&bar[XB_XGEN(b.x)], 1u);
            asm volatile("s_waitcnt vmcnt(0)" ::: "memory");
        } else {
            XB_SPIN(xb_ld(&bar[XB_XGEN(b.x)]) == gen, bar);
            __builtin_amdgcn_fence(__ATOMIC_ACQUIRE, "agent");
            asm volatile("s_waitcnt vmcnt(0)" ::: "memory");
        }
    }
    __syncthreads();
}

struct Args { const float* in[20]; float* out; unsigned char* ws; };

__global__ void __launch_bounds__(NWAVES * 64, 2) fwd_kernel(Args args) {
    extern __shared__ __attribute__((aligned(16))) unsigned char lds_raw[];
    cg::grid_group grid = cg::this_grid();
    LAS unsigned char* lds = (LAS unsigned char*)lds_raw;
    const int tid = threadIdx.x, lane = tid & 63, wave = __builtin_amdgcn_readfirstlane(tid >> 6), fr_k = lane & 15, fq_k = lane >> 4, lane_k = lane;
    const int G = gridDim.x, bid = blockIdx.x, gw = bid * NWAVES + wave, NGW = G * NWAVES;
    unsigned char* ws = args.ws;
    volatile LAS unsigned* MISC = (volatile LAS unsigned*)(lds + LDS_BYTES - 64);
    if (tid < 16) MISC[tid] = 0u;
    __syncthreads();
    XcdBarrier xbar = xcd_barrier_post((unsigned*)(ws + WS_BAR), MISC);
#define GRID_BAR() xcd_barrier(xbar)
    const float* x = args.in[0]; const float* ln1_g = args.in[1]; const float* w_in = args.in[2]; const float* pool_w = args.in[3]; const float* pool_scale = args.in[4];
    const float* conv_w = args.in[5]; const float* conv_b = args.in[6]; const float* w_a = args.in[7]; const float* b_a = args.in[8]; const float* w_i = args.in[9]; const float* b_i = args.in[10];
    const float* lam = args.in[11]; const float* gn_pool_g = args.in[12]; const float* gn_lru_g = args.in[13]; const float* w_out = args.in[14]; const float* ln2_g = args.in[15];
    const float* w_gate = args.in[16]; const float* w_up = args.in[17]; const float* w_down = args.in[18]; const float* lnf_g = args.in[19];
    float* out = args.out;
    float* ss2 = (float*)(ws + WS_SS2); float* ss3 = (float*)(ws + WS_SS3); float* nsp = (float*)(ws + WS_NSP);
    bf16* poolwT = (bf16*)(ws + WS_POOLWT); bf16* waT = (bf16*)(ws + WS_WAT); bf16* wiT = (bf16*)(ws + WS_WIT);
    float* aggA = (float*)(ws + WS_AGGA); float* aggB = (float*)(ws + WS_AGGB);
    bf16* WinT = (bf16*)(ws + WS_WIN); bf16* WoutT = (bf16*)(ws + WS_WOUT); bf16* WguT = (bf16*)(ws + WS_WGU); bf16* WdT = (bf16*)(ws + WS_WD);
    bf16* xn = (bf16*)(ws + WS_X1); bf16* mix = (bf16*)(ws + WS_X1); bf16* proj = (bf16*)(ws + WS_X2); bf16* hb = (bf16*)(ws + WS_X2); bf16* act = (bf16*)(ws + WS_ACT);

    {
        for (int i = bid * 512 + tid; i < 2 * M; i += G * 512) ss2[i] = 0.f;
        if (bid == 0) nsp[tid] = -8.0f * log1pf(expf(-lam[tid]));
        LAS float* scr = (LAS float*)(lds + wave * 16384);
        constexpr int I_IN = (D / 64) * (NIN / 32), I_OUT = (D / 64) * (D / 32), I_G = (D / 64) * (DFF / 32), I_D = (DFF / 64) * (D / 32), I_P = 4 * 2 * 4, I_A = 8 * 2;
        constexpr int NITEMS = I_IN + I_OUT + 2 * I_G + I_D + I_P + 2 * I_A;
        for (int it = gw; it < NITEMS; it += NGW) {
            int r = it;
            if (r < I_IN) { const int kb = r / (NIN / 32), nb = r % (NIN / 32); tr_item(w_in, NIN, 64 * kb, 32 * nb, WinT + (size_t)(32 * nb) * D + 64 * kb, D, scr, lane); continue; } r -= I_IN;
            if (r < I_OUT) { const int kb = r / (D / 32), nb = r % (D / 32); tr_item(w_out, D, 64 * kb, 32 * nb, WoutT + (size_t)(32 * nb) * D + 64 * kb, D, scr, lane); continue; } r -= I_OUT;
            if (r < 2 * I_G) { const int up = r >= I_G ? 1 : 0; r -= up * I_G; const int kb = r / (DFF / 32), nb = r % (DFF / 32), n0 = 32 * nb, drow = 256 * (n0 / 128) + (n0 % 128) + 128 * up;
                tr_item(up ? w_up : w_gate, DFF, 64 * kb, n0, WguT + (size_t)drow * D + 64 * kb, D, scr, lane); continue; } r -= 2 * I_G;
            if (r < I_D) { const int kb = r / (D / 32), nb = r % (D / 32); tr_item(w_down, D, 64 * kb, 32 * nb, WdT + (size_t)(32 * nb) * DFF + 64 * kb, DFF, scr, lane); continue; } r -= I_D;
            if (r < I_P) { const int g = r / 8, kb = (r % 8) / 4, nb = r % 4; tr_item(pool_w + g * 16384, 128, 64 * kb, 32 * nb, poolwT + g * 16384 + (32 * nb) * 128 + 64 * kb, 128, scr, lane); continue; } r -= I_P;
            { const int wi = r >= I_A ? 1 : 0; r -= wi * I_A; const int h = r / 2, nb = r % 2; tr_item((wi ? w_i : w_a) + h * 4096, 64, 0, 32 * nb, (wi ? wiT : waT) + h * 4096 + (32 * nb) * 64, 64, scr, lane); }
        }
        f32x4 gv[4];
#pragma unroll
        for (int j = 0; j < 4; ++j) gv[j] = ((const f32x4*)ln1_g)[lane + 64 * j];
        for (int m = gw; m < M; m += NGW) {
            const f32x4* xr = (const f32x4*)(x + (size_t)m * D) + lane; f32x4 v[4]; float s = 0.f;
#pragma unroll
            for (int j = 0; j < 4; ++j) { v[j] = xr[64 * j]; s += (v[j].x * v[j].x + v[j].y * v[j].y) + (v[j].z * v[j].z + v[j].w * v[j].w); }
            const float rs = __builtin_amdgcn_rsqf(wave_sum(s) * (1.f / D) + EPS);
            u32x2* o8 = (u32x2*)(xn + (size_t)m * D) + lane;
#pragma unroll
            for (int j = 0; j < 4; ++j) { const f32x4 y = (v[j] * rs) * gv[j]; u32x2 w; w.x = pk2(y.x, y.y); w.y = pk2(y.z, y.w); o8[64 * j] = w; }
        }
    }
    grid.sync();

#if !defined(SKIP_P1)
    {
        pg8::Gemm g{xn, WinT, M, NIN, D}; pg8::StaticOrder S; S.init(M, NIN, G, bid);
        pg8::EpiStoreBf16 E{proj, NIN};
        pg8::gemm_phase<pg8::EpiStoreBf16, pg8::StaticOrder, true, true>(lds, g, S, E);
    }
    GRID_BAR();

#endif
#if !defined(SKIP_P2)
    {
        constexpr int PSTR = 1040;
        constexpr int XSTR = 144, XWAVE = CH * XSTR;
        constexpr int RED_OFF = 80 * 1024, RED2_OFF = 82 * 1024;
        LAS float* red = (LAS float*)(lds + RED_OFF); LAS float* red2 = (LAS float*)(lds + RED2_OFF); LAS float* cyl = (LAS float*)(lds + RED2_OFF + 2048);
#ifndef REP_P2
#define REP_P2 1
#endif
        for (int rep2 = 0; rep2 < REP_P2; ++rep2)
        for (int base = 0; base < NT2; base += G) {
            const int tile = base + bid; const bool active = tile < NT2;
            const int bidx = tile / NCHUNK, cidx = tile % NCHUNK, t0 = cidx * CH; const size_t rowb = (size_t)bidx * SEQ;
            int fr = fr_k, fq = fq_k, lane = lane_k; asm volatile("" : "+v"(fr), "+v"(fq), "+v"(lane));
            const int h = wave, chl = h * 64 + 4 * fq;
            f32x4 xc[MT][4], av[MT][4];
            if (active) {
#if !defined(SKIP_POOL)
#pragma unroll
                for (int g = 0; g < 4; ++g) {
                    const int W = 2 << g;
#pragma unroll
                    for (int it = 0; it < MT / 2; ++it) {
                        const int tl = wave * (2 * MT) + it * 4 + (lane >> 4), cv = lane & 15, ch = g * 128 + cv * 8, pos = t0 + tl;
                        const bf16* p = proj + (rowb + pos) * NIN + ch;
                        const u32x4 c = *(const u32x4*)p;
                        float s[8], c8[8];
#pragma unroll
                        for (int e = 0; e < 4; ++e) { c8[2 * e] = __uint_as_float(c[e] << 16); c8[2 * e + 1] = __uint_as_float(c[e] & 0xffff0000u); s[2 * e] = c8[2 * e]; s[2 * e + 1] = c8[2 * e + 1]; }
#pragma unroll
                        for (int j = 1; j < W; ++j) { const int pj = pos - j; const float mk = pj >= 0 ? 1.f : 0.f; const u32x4 v = *(const u32x4*)(proj + (rowb + (pj >= 0 ? pj : 0)) * NIN + ch);
#pragma unroll
                            for (int e = 0; e < 4; ++e) { s[2 * e] += mk * __uint_as_float(v[e] << 16); s[2 * e + 1] += mk * __uint_as_float(v[e] & 0xffff0000u); } }
                        const float inv = 1.0f / (float)(pos + 1 < W ? pos + 1 : W);
                        u32x4 o;
#pragma unroll
                        for (int e = 0; e < 4; ++e) o[e] = pk2(s[2 * e] * inv - c8[2 * e], s[2 * e + 1] * inv - c8[2 * e + 1]);
                        *(LAS u32x4*)(lds + tl * PSTR + ch * 2) = o;
                    }
                }
                {
                    const int g = wave >> 1, nh = wave & 1, chp = g * 128 + nh * 64 + 4 * fq;
                    bf16x8 wf[4][4];
#pragma unroll
                    for (int n = 0; n < 4; ++n)
#pragma unroll
                        for (int ks = 0; ks < 4; ++ks) wf[n][ks] = *(const bf16x8*)(poolwT + (size_t)(g * 128 + nh * 64 + n * 16 + fr) * 128 + ks * 32 + fq * 8);
                    __syncthreads();
                    f32x4 acc[MT][4];
#pragma unroll
                    for (int m = 0; m < MT; ++m)
#pragma unroll
                        for (int n = 0; n < 4; ++n) acc[m][n] = (f32x4){0.f, 0.f, 0.f, 0.f};
#pragma unroll
                    for (int m = 0; m < MT; ++m)
#pragma unroll
                        for (int ks = 0; ks < 4; ++ks) { const bf16x8 xf = *(const LAS bf16x8*)(lds + (16 * m + fr) * PSTR + (g * 128 + ks * 32 + fq * 8) * 2);
#pragma unroll
                            for (int n = 0; n < 4; ++n) acc[m][n] = __builtin_amdgcn_mfma_f32_16x16x32_bf16(wf[n][ks], xf, acc[m][n], 0, 0, 0); }
                    f32x4 psc[4], pg[4];
#pragma unroll
                    for (int n = 0; n < 4; ++n) { psc[n] = *(const f32x4*)(pool_scale + chp + 16 * n); pg[n] = *(const f32x4*)(gn_pool_g + chp + 16 * n); }
#pragma unroll
                    for (int m = 0; m < MT; ++m) { float ss = 0.f;
#pragma unroll
                        for (int n = 0; n < 4; ++n) { acc[m][n] = acc[m][n] * psc[n]; const f32x4 y = acc[m][n]; ss += (y[0] * y[0] + y[1] * y[1]) + (y[2] * y[2] + y[3] * y[3]); }
                        ss += __shfl_xor(ss, 16); ss += __shfl_xor(ss, 32);
                        if (fq == 0) red[(16 * m + fr) * 8 + wave] = ss; }
                    __syncthreads();
#pragma unroll
                    for (int m = 0; m < MT; ++m) { const f32x4 r0 = *(const LAS f32x4*)(red + (16 * m + fr) * 8), r1 = *(const LAS f32x4*)(red + (16 * m + fr) * 8 + 4);
                        const float tot = ((r0[0] + r0[1]) + (r0[2] + r0[3])) + ((r1[0] + r1[1]) + (r1[2] + r1[3]));
                        const float rs = __builtin_amdgcn_rsqf(tot * (1.f / PW) + EPS);
                        bf16* mp = mix + (rowb + t0 + 16 * m + fr) * D + chp;
#pragma unroll
                        for (int n = 0; n < 4; ++n) { const f32x4 y = (acc[m][n] * rs) * pg[n]; u32x2 w; w.x = pk2(y[0], y[1]); w.y = pk2(y[2], y[3]); *(u32x2*)(mp + 16 * n) = w; } }
                }
#endif
                LAS unsigned char* lx = lds + wave * XWAVE;
#pragma unroll
                for (int n = 0; n < 4; ++n) {
                    const int chn = chl + 16 * n;
                    f32x4 cw[4];
#pragma unroll
                    for (int k = 0; k < 4; ++k) cw[k] = *(const f32x4*)(conv_w + k * LW + chn);
                    const f32x4 cb = *(const f32x4*)(conv_b + chn);
                    f32x4 u[MT + 3];
#pragma unroll
                    for (int r = 0; r < MT + 3; ++r) { const int pos = t0 + MT * fr - 3 + r; const u32x2 raw = *(const u32x2*)(proj + (rowb + (pos >= 0 ? pos : 0)) * NIN + PW + chn);
                        u[r] = bf4_to_f32(raw); if (pos < 0) u[r] = (f32x4){0.f, 0.f, 0.f, 0.f}; }
#pragma unroll
                    for (int m = 0; m < MT; ++m) { const f32x4 v = cb + cw[0] * u[m] + cw[1] * u[m + 1] + cw[2] * u[m + 2] + cw[3] * u[m + 3]; xc[m][n] = v;
                        u32x2 w; w.x = pk2(v[0], v[1]); w.y = pk2(v[2], v[3]); *(LAS u32x2*)(lx + (m * 16 + fr) * XSTR + (n * 16 + 4 * fq) * 2) = w; }
                }
                LDS_WAIT();
#pragma unroll
                for (int n = 0; n < 4; ++n) {
                    const int chn = chl + 16 * n;
                    bf16x8 waf[2], wif[2];
#pragma unroll
                    for (int ks = 0; ks < 2; ++ks) { waf[ks] = *(const bf16x8*)(waT + (size_t)(h * 64 + n * 16 + fr) * 64 + ks * 32 + fq * 8); wif[ks] = *(const bf16x8*)(wiT + (size_t)(h * 64 + n * 16 + fr) * 64 + ks * 32 + fq * 8); }
                    const f32x4 ba = *(const f32x4*)(b_a + chn), bi = *(const f32x4*)(b_i + chn), sp = *(const f32x4*)(nsp + chn);
#pragma unroll
                    for (int m = 0; m < MT; ++m) {
                            const bf16x8 xf0 = *(const LAS bf16x8*)(lx + (m * 16 + fr) * XSTR + (fq * 8) * 2), xf1 = *(const LAS bf16x8*)(lx + (m * 16 + fr) * XSTR + (32 + fq * 8) * 2);
                        f32x4 ra = (f32x4){0.f, 0.f, 0.f, 0.f}, ia = (f32x4){0.f, 0.f, 0.f, 0.f};
                        ra = __builtin_amdgcn_mfma_f32_16x16x32_bf16(waf[0], xf0, ra, 0, 0, 0); ra = __builtin_amdgcn_mfma_f32_16x16x32_bf16(waf[1], xf1, ra, 0, 0, 0);
                        ia = __builtin_amdgcn_mfma_f32_16x16x32_bf16(wif[0], xf0, ia, 0, 0, 0); ia = __builtin_amdgcn_mfma_f32_16x16x32_bf16(wif[1], xf1, ia, 0, 0, 0);
#pragma unroll
                        for (int j = 0; j < 4; ++j) { const float rr = sigmoidf_(ra[j] + ba[j]), ii = sigmoidf_(ia[j] + bi[j]); const float la = rr * sp[j];
                            const float a = __expf(la), x2 = 2.0f * la;
                            const float pl = -x2 * (1.0f + x2 * (0.5f + x2 * (0.16666667f + x2 * (0.041666668f + x2 * (0.0083333338f + x2 * (0.0013888889f + x2 * 0.0001984127f))))));
                            const float mult = __builtin_amdgcn_sqrtf(fmaxf(x2 > -0.25f ? pl : 1.0f - a * a, 0.0f));
                            av[m][n][j] = a; xc[m][n][j] = mult * ii * xc[m][n][j]; }
                    }
                }
#pragma unroll
                for (int n = 0; n < 4; ++n)
#pragma unroll
                    for (int j = 0; j < 4; ++j) {
#pragma unroll
                        for (int m = 1; m < MT; ++m) { xc[m][n][j] = av[m][n][j] * xc[m - 1][n][j] + xc[m][n][j]; av[m][n][j] = av[m][n][j] * av[m - 1][n][j]; }
                        float Pi = av[MT - 1][n][j], Hi = xc[MT - 1][n][j], ap, hp;
                        ap = dpp_f<0x111>(1.0f, Pi); hp = dpp_f<0x111>(0.0f, Hi); Hi = Pi * hp + Hi; Pi = Pi * ap;
                        ap = dpp_f<0x112>(1.0f, Pi); hp = dpp_f<0x112>(0.0f, Hi); Hi = Pi * hp + Hi; Pi = Pi * ap;
                        ap = dpp_f<0x114>(1.0f, Pi); hp = dpp_f<0x114>(0.0f, Hi); Hi = Pi * hp + Hi; Pi = Pi * ap;
                        ap = dpp_f<0x118>(1.0f, Pi); hp = dpp_f<0x118>(0.0f, Hi); Hi = Pi * hp + Hi; Pi = Pi * ap;
                        const float Pe = dpp_f<0x111>(1.0f, Pi), He = dpp_f<0x111>(0.0f, Hi);
#pragma unroll
                        for (int m = 0; m < MT; ++m) { xc[m][n][j] = xc[m][n][j] + av[m][n][j] * He; av[m][n][j] = av[m][n][j] * Pe; }
                    }
                if (fr == 15) {
#pragma unroll
                    for (int n = 0; n < 4; ++n) { *(f32x4*)(aggA + (size_t)tile * LW + chl + 16 * n) = av[MT - 1][n]; *(f32x4*)(aggB + (size_t)tile * LW + chl + 16 * n) = xc[MT - 1][n]; }
                }
            }
            GRID_BAR();
            if (active) {
                {
                    float cy = 0.f; const float* pa = aggA + (size_t)(bidx * NCHUNK) * LW + tid; const float* pb = aggB + (size_t)(bidx * NCHUNK) * LW + tid;
#pragma unroll 16
                    for (int jc = 0; jc < cidx; ++jc) cy = pa[(size_t)jc * LW] * cy + pb[(size_t)jc * LW];
                    cyl[tid] = cy;
                }
                __syncthreads();
                f32x4 carry[4];
#pragma unroll
                for (int n = 0; n < 4; ++n) carry[n] = *(const LAS f32x4*)(cyl + chl + 16 * n);
                f32x4 gl[4];
#pragma unroll
                for (int n = 0; n < 4; ++n) gl[n] = *(const f32x4*)(gn_lru_g + chl + 16 * n);
#pragma unroll
                for (int m = 0; m < MT; ++m) { float ss = 0.f; const bf16* gp = proj + (rowb + t0 + MT * fr + m) * NIN + PW + LW + chl;
#pragma unroll
                    for (int n = 0; n < 4; ++n) { const f32x4 hh = xc[m][n] + av[m][n] * carry[n]; const f32x4 gt = bf4_to_f32(*(const u32x2*)(gp + 16 * n)); f32x4 y;
#pragma unroll
                        for (int j = 0; j < 4; ++j) { const float z = gt[j]; y[j] = hh[j] * z * sigmoidf_(1.5957691216f * (z + 0.044715f * z * z * z)); }
                        xc[m][n] = y; ss += (y[0] * y[0] + y[1] * y[1]) + (y[2] * y[2] + y[3] * y[3]); }
                    ss += __shfl_xor(ss, 16); ss += __shfl_xor(ss, 32);
                    if (fq == 0) red2[(MT * fr + m) * 8 + wave] = ss; }
                __syncthreads();
#pragma unroll
                for (int m = 0; m < MT; ++m) { const f32x4 r0 = *(const LAS f32x4*)(red2 + (MT * fr + m) * 8), r1 = *(const LAS f32x4*)(red2 + (MT * fr + m) * 8 + 4);
                    const float tot = ((r0[0] + r0[1]) + (r0[2] + r0[3])) + ((r1[0] + r1[1]) + (r1[2] + r1[3]));
                    const float rs = __builtin_amdgcn_rsqf(tot * (1.f / LW) + EPS);
                    bf16* mp = mix + (rowb + t0 + MT * fr + m) * D + PW + chl;
#pragma unroll
                    for (int n = 0; n < 4; ++n) { const f32x4 y = (xc[m][n] * rs) * gl[n]; u32x2 w; w.x = pk2(y[0], y[1]); w.y = pk2(y[2], y[3]); *(u32x2*)(mp + 16 * n) = w; } }
                __syncthreads();
            }
        }
    }
    GRID_BAR();

#endif
#if !defined(SKIP_P3)
#ifdef EXTRA_SYNCS
    for (int es = 0; es < EXTRA_SYNCS; ++es) grid.sync();
#endif
    {
        pg8::Gemm g{mix, WoutT, M, D, D}; pg8::StaticOrder S; S.init(M, D, G, bid);
        pg8::EpiResid<true> E{x, out, hb, ln2_g, ss2, D};
        pg8::gemm_phase<pg8::EpiResid<true>, pg8::StaticOrder, true, true>(lds, g, S, E);
    }
    GRID_BAR();

#endif
#if !defined(SKIP_P4)
    {
        pg8::Gemm g{hb, WguT, M, NGU, D}; pg8::StaticOrder S; S.init(M, NGU, G, bid);
        pg8::EpiSwiGLU E{act, DFF, ss2, 1.f / D, EPS};
        pg8::gemm_phase<pg8::EpiSwiGLU, pg8::StaticOrder, true, true>(lds, g, S, E);
    }
    GRID_BAR();

#endif
#if !defined(SKIP_P5)
    {
        pg8::Gemm g{act, WdT, M, D, DFF}; pg8::StaticOrder S; S.init(M, D, G, bid);
        pg8::EpiResid<false> E{out, out, nullptr, nullptr, ss3, D};
        pg8::gemm_phase<pg8::EpiResid<false>, pg8::StaticOrder, true, true>(lds, g, S, E);
    }
    GRID_BAR();

#endif
    {
        f32x4 gv[4];
#pragma unroll
        for (int j = 0; j < 4; ++j) gv[j] = ((const f32x4*)lnf_g)[lane + 64 * j];
        for (int m = gw; m < M; m += NGW) {
            f32x4* xr = (f32x4*)(out + (size_t)m * D) + lane;
            const float rs = __builtin_amdgcn_rsqf(ss3[m] * (1.f / D) + EPS);
#pragma unroll
            for (int j = 0; j < 4; ++j) { const f32x4 v = xr[64 * j]; xr[64 * j] = (v * rs) * gv[j]; }
        }
    }
}

extern "C" void kernel_launch(void* const* d_in, const int* in_sizes, int n_in, void* d_out, int out_size, void* d_ws, size_t ws_size, hipStream_t stream) {
    static int grid = 0;
    if (grid == 0) {
        if (n_in != 20 || in_sizes[0] != M * D || out_size != M * D || ws_size < WS_END) { fprintf(stderr, "kernel_launch: unexpected shapes (n_in %d, in0 %d, out %d, ws %zu)\n", n_in, n_in > 0 ? in_sizes[0] : -1, out_size, ws_size); grid = -1; return; }
        int dev = 0, cus = 0, per_cu = 0;
        (void)hipGetDevice(&dev); (void)hipDeviceGetAttribute(&cus, hipDeviceAttributeMultiprocessorCount, dev);
        if (hipFuncSetAttribute((const void*)fwd_kernel, hipFuncAttributeMaxDynamicSharedMemorySize, LDS_BYTES) != hipSuccess) { fprintf(stderr, "kernel_launch: hipFuncSetAttribute failed\n"); grid = -1; return; }
        if (hipOccupancyMaxActiveBlocksPerMultiprocessor(&per_cu, (const void*)fwd_kernel, NWAVES * 64, LDS_BYTES) != hipSuccess || per_cu < 1) per_cu = 1;
        (void)hipGetLastError();
        if (cus < 1) cus = 256;
        grid = cus * per_cu;
    }
    if (grid < 0) return;
    if (hipMemsetAsync((char*)d_ws + WS_BAR, 0, BAR_BYTES, stream) != hipSuccess) { fprintf(stderr, "kernel_launch: hipMemsetAsync failed\n"); return; }
    Args a{};
    for (int i = 0; i < 20; ++i) a.in[i] = (const float*)d_in[i];
    a.out = (float*)d_out; a.ws = (unsigned char*)d_ws;
    void* kargs[] = {&a};
    hipError_t e = hipLaunchCooperativeKernel((const void*)fwd_kernel, dim3(grid), dim3(NWAVES * 64), kargs, LDS_BYTES, stream);
    if (e != hipSuccess) fprintf(stderr, "kernel_launch: cooperative launch failed: %s (grid %d)\n", hipGetErrorString(e), grid);
}
```

```cpp
#include <hip/hip_runtime.h>
#include <hip/hip_cooperative_groups.h>
#include <cstdio>
#include <cstdint>
namespace cg = cooperative_groups;
namespace pg8 {
#define PG8_LAS __attribute__((address_space(3)))
typedef unsigned short bf16_t;
typedef short bf16x8 __attribute__((ext_vector_type(8)));
typedef float f32x4 __attribute__((ext_vector_type(4)));
typedef unsigned u32x4 __attribute__((ext_vector_type(4)));
constexpr int BM = 256, BK = 64, HALF = 128, HTB = HALF * BK * 2  , STAGE_BYTES = 8 * HTB, NXCD = 8, WGM = 8;

__host__ __device__ __forceinline__ int lds_byte(int r, int c) { const int st = (r >> 4) * 2 + (c >> 5), rr = r & 15, cc = c & 31, ob = rr * 64 + cc * 2; return st * 1024 + (ob ^ (((ob >> 9) & 1) << 5)); }
__host__ __device__ __forceinline__ void stage_rc(int b, int& R, int& C) { const int st = b / 1024, sb = b % 1024, swz = sb ^ (((sb >> 9) & 1) << 5); R = (st >> 1) * 16 + swz / 64; C = (st & 1) * 32 + (swz % 64) / 2; }
__host__ __device__ __forceinline__ int perm32(int rho) { const int n = rho >> 4, i = rho & 15; return 8 * (i >> 2) + 4 * n + (i & 3); }

struct Unit { int pm, pn; };
struct Gemm { const bf16_t* A; const bf16_t* Bt; int M, N, K; };

struct StaticOrder {
    int nM, nN, nwg, G, c;
    __host__ __device__ void init(int M, int N, int G_, int c_) { nM = M / BM; nN = N / BM; nwg = nM * nN; G = G_; c = c_; }
    __host__ __device__ bool next(int i, Unit& u) const {
        const long L = (long)i * G + c; if (L >= nwg) return false;
        int wgid = (int)L; { const int q = nwg / NXCD, r = nwg % NXCD, xcd = wgid % NXCD, off = wgid / NXCD; wgid = (xcd < r ? xcd * (q + 1) : r * (q + 1) + (xcd - r) * q) + off; }
        const int nig = WGM * nN, gid = wgid / nig, fm = gid * WGM, gsz = (nM - fm) < WGM ? (nM - fm) : WGM;
        u.pm = fm + ((wgid % nig) % gsz); u.pn = (wgid % nig) / gsz; return true;
    }
    __device__ __forceinline__ void a_ready(const Unit&) const {}
    __device__ __forceinline__ void done(const Unit&) const {}
};

__device__ __forceinline__ unsigned cvt_pk_bf16(float lo, float hi) { unsigned r; asm volatile("v_cvt_pk_bf16_f32 %0, %1, %2" : "=v"(r) : "v"(lo), "v"(hi)); return r; }
typedef unsigned u32x2 __attribute__((ext_vector_type(2)));
struct EpiStoreBf16 {
    static constexpr bool PERM = true, AFTER_DRAIN = false;
    bf16_t* O; int ldc;
    __device__ __forceinline__ void operator()(const f32x4 (&acc)[2][2][4][2], const Unit& u, int wr, int wc, int fr, int fq) const {
        const int row0 = u.pm * BM + wr * 64 + fr, col0 = u.pn * BM + wc * 32 + 8 * fq;
#pragma unroll
        for (int ai = 0; ai < 2; ++ai)
#pragma unroll
            for (int m = 0; m < 4; ++m) { bf16_t* rowp = O + (size_t)(row0 + ai * HALF + m * 16) * ldc + col0;
#pragma unroll
                for (int bj = 0; bj < 2; ++bj) { const f32x4 v0 = acc[ai][bj][m][0], v1 = acc[ai][bj][m][1];
                    u32x4 w; w.x = cvt_pk_bf16(v0[0], v0[1]); w.y = cvt_pk_bf16(v0[2], v0[3]); w.z = cvt_pk_bf16(v1[0], v1[1]); w.w = cvt_pk_bf16(v1[2], v1[3]);
                    *(u32x4*)(rowp + bj * HALF) = w; } }
    }
};
struct EpiSwiGLU {
    static constexpr bool PERM = true, AFTER_DRAIN = false;
    bf16_t* O; int ldo; const float* sumsq; float inv_n, eps;
    __device__ __forceinline__ void operator()(const f32x4 (&acc)[2][2][4][2], const Unit& u, int wr, int wc, int fr, int fq) const {
        const int row0 = u.pm * BM + wr * 64 + fr, col0 = u.pn * HALF + wc * 32 + 8 * fq;
#pragma unroll
        for (int ai = 0; ai < 2; ++ai)
#pragma unroll
            for (int m = 0; m < 4; ++m) { const int row = row0 + ai * HALF + m * 16;
                const float rs = __builtin_amdgcn_rsqf(sumsq[row] * inv_n + eps);
                float o[8];
#pragma unroll
                for (int n = 0; n < 2; ++n)
#pragma unroll
                    for (int j = 0; j < 4; ++j) { const float g = acc[ai][0][m][n][j] * rs, up = acc[ai][1][m][n][j] * rs;
                        o[n * 4 + j] = g * __builtin_amdgcn_rcpf(1.0f + __expf(-g)) * up; }
                u32x4 w; w.x = cvt_pk_bf16(o[0], o[1]); w.y = cvt_pk_bf16(o[2], o[3]); w.z = cvt_pk_bf16(o[4], o[5]); w.w = cvt_pk_bf16(o[6], o[7]);
                *(u32x4*)(O + (size_t)row * ldo + col0) = w; }
    }
};
template <bool WITH_HB> struct EpiResid {
    static constexpr bool PERM = false, AFTER_DRAIN = false;
    const float* base; float* out; bf16_t* hb; const float* g; float* sumsq; int ldc;
    __device__ __forceinline__ void operator()(const f32x4 (&acc)[2][2][4][2], const Unit& u, int wr, int wc, int fr, int fq) const {
        const int col0 = u.pn * BM + wc * 32 + 4 * fq;
        f32x4 gv[2][2];
        if (WITH_HB) {
#pragma unroll
            for (int bj = 0; bj < 2; ++bj)
#pragma unroll
                for (int n = 0; n < 2; ++n) gv[bj][n] = *(const f32x4*)(g + col0 + bj * HALF + n * 16);
        }
#pragma unroll
        for (int ai = 0; ai < 2; ++ai)
#pragma unroll
            for (int m = 0; m < 4; ++m) { const int r = u.pm * BM + ai * HALF + wr * 64 + m * 16 + fr; const size_t off = (size_t)r * ldc + col0; float ss = 0.f;
#pragma unroll
                for (int bj = 0; bj < 2; ++bj)
#pragma unroll
                    for (int n = 0; n < 2; ++n) { const f32x4 bs = *(const f32x4*)(base + off + bj * HALF + n * 16); const f32x4 h = bs + acc[ai][bj][m][n];
                        *(f32x4*)(out + off + bj * HALF + n * 16) = h; ss += (h[0] * h[0] + h[1] * h[1]) + (h[2] * h[2] + h[3] * h[3]);
                        if (WITH_HB) { const f32x4 hg = h * gv[bj][n]; u32x2 w; w.x = cvt_pk_bf16(hg[0], hg[1]); w.y = cvt_pk_bf16(hg[2], hg[3]); *(u32x2*)(hb + off + bj * HALF + n * 16) = w; } }
                ss += __shfl_xor(ss, 16); ss += __shfl_xor(ss, 32);
                if (fq == 0) atomicAdd(sumsq + r, ss);
                if (m & 1) asm volatile("" ::: "memory"); }
    }
};
template <class Epi, class Sched, bool ALIGN_EPI = false, bool SP2 = false>
__device__ __forceinline__ void gemm_phase(PG8_LAS unsigned char* lds, const Gemm g, const Sched& S, const Epi& E) {
    const int tid = threadIdx.x, wid = __builtin_amdgcn_readfirstlane(tid >> 6), lane = tid & 63, wr = wid >> 2, wc = wid & 3, fr = lane & 15, fq = lane >> 4;
    const int K = g.K, nt = K / BK;
    unsigned voffA[2], voffB[2];
#pragma unroll
    for (int i = 0; i < 2; ++i) { int R, C; stage_rc(tid * 16 + i * 8192, R, C); const int Rb = Epi::PERM ? ((R & ~31) + perm32(R & 31)) : R;
        voffA[i] = (unsigned)(R * K + C) * 2u; voffB[i] = (unsigned)(Rb * K + C) * 2u; }
    const size_t kstep = (size_t)(BK * 2);
    const size_t hstep = (size_t)HALF * K * 2;
    const size_t tstep = 2 * hstep;
    const unsigned ldsw = (unsigned)wid * 1024u;
    const int aoff = lds_byte(wr * 64 + fr, fq * 8), boff = lds_byte(wc * 32 + fr, fq * 8);
#define PG8_SA(b, h) (((b) * 2 + (h)) * HTB)
#define PG8_SB(b, h) ((4 + (b) * 2 + (h)) * HTB)
#define PG8_STAGE(bufoff, gbase, voff) do { _Pragma("unroll") for (int _i = 0; _i < 2; ++_i) \
        __builtin_amdgcn_global_load_lds((const unsigned*)((const char*)(gbase) + (voff)[_i]), (PG8_LAS unsigned*)(lds + (bufoff) + ldsw + _i * 8192), 16, 0, 0); } while (0)
#define PG8_LDA(dst, b, h) do { _Pragma("unroll") for (int m = 0; m < 4; ++m) _Pragma("unroll") for (int k = 0; k < 2; ++k) dst[m][k] = *(const PG8_LAS bf16x8*)(lds + PG8_SA(b, h) + aoff + m * 2048 + k * 1024); } while (0)
#define PG8_LDB(dst, b, h) do { _Pragma("unroll") for (int n = 0; n < 2; ++n) _Pragma("unroll") for (int k = 0; k < 2; ++k) dst[n][k] = *(const PG8_LAS bf16x8*)(lds + PG8_SB(b, h) + boff + n * 2048 + k * 1024); } while (0)
#define PG8_MMA(ai, bj, At, Bt) do { __builtin_amdgcn_s_setprio(1); _Pragma("unroll") for (int m = 0; m < 4; ++m) _Pragma("unroll") for (int n = 0; n < 2; ++n) _Pragma("unroll") for (int k = 0; k < 2; ++k) \
        acc[ai][bj][m][n] = __builtin_amdgcn_mfma_f32_16x16x32_bf16(Bt[n][k], At[m][k], acc[ai][bj][m][n], 0, 0, 0); __builtin_amdgcn_s_setprio(0); } while (0)
#define PG8_WAIT_V(n) asm volatile("s_waitcnt vmcnt(" #n ")" ::: "memory")
#define PG8_WAIT_L(n) asm volatile("s_waitcnt lgkmcnt(" #n ")" ::: "memory")
#define PG8_BAR __builtin_amdgcn_s_barrier()
#define PG8_SCHED __builtin_amdgcn_sched_barrier(0)
    Unit cur, nxt; int ui = 0;
    if (!S.next(0, cur)) return;
    f32x4 acc[2][2][4][2];
#pragma unroll
    for (int a = 0; a < 2; ++a)
#pragma unroll
        for (int b = 0; b < 2; ++b)
#pragma unroll
            for (int m = 0; m < 4; ++m)
#pragma unroll
                for (int n = 0; n < 2; ++n) acc[a][b][m][n] = (f32x4){0.f, 0.f, 0.f, 0.f};
    bf16x8 At[4][2], B0[2][2], B1[2][2];
    const char* cA = (const char*)g.A + (size_t)cur.pm * tstep; const char* cB = (const char*)g.Bt + (size_t)cur.pn * tstep;
    S.a_ready(cur);
    if constexpr (SP2) {
        PG8_STAGE(PG8_SB(0, 0), cB, voffB); PG8_STAGE(PG8_SB(0, 1), cB + hstep, voffB); PG8_STAGE(PG8_SA(0, 0), cA, voffA); PG8_STAGE(PG8_SA(0, 1), cA + hstep, voffA);
        if (wr == 1) PG8_BAR;
        PG8_WAIT_V(2); PG8_BAR;
        PG8_STAGE(PG8_SB(1, 0), cB + kstep, voffB); PG8_STAGE(PG8_SA(1, 0), cA + kstep, voffA); PG8_STAGE(PG8_SB(1, 1), cB + hstep + kstep, voffB);
        PG8_WAIT_V(6); PG8_BAR;
    } else {
        PG8_STAGE(PG8_SB(0, 0), cB, voffB); PG8_STAGE(PG8_SA(0, 0), cA, voffA); PG8_STAGE(PG8_SB(0, 1), cB + hstep, voffB); PG8_STAGE(PG8_SA(0, 1), cA + hstep, voffA);
        if (wr == 1) PG8_BAR;
        PG8_WAIT_V(4); PG8_BAR;
        PG8_STAGE(PG8_SB(1, 0), cB + kstep, voffB); PG8_STAGE(PG8_SA(1, 0), cA + kstep, voffA); PG8_STAGE(PG8_SB(1, 1), cB + hstep + kstep, voffB);
        PG8_WAIT_V(6); PG8_BAR;
    }
    for (;;) {
        const bool has_next = S.next(ui + 1, nxt);
        const char* nA = has_next ? (const char*)g.A + (size_t)nxt.pm * tstep : cA; const char* nB = has_next ? (const char*)g.Bt + (size_t)nxt.pn * tstep : cB;
        for (int t = 0; t < nt; t += 2) {
            const bool last = (t == nt - 2);
            const char* a1 = cA + (size_t)(t + 1) * kstep;
            const char* a2 = last ? nA : cA + (size_t)(t + 2) * kstep; const char* b2 = last ? nB : cB + (size_t)(t + 2) * kstep;
            const char* a3 = a2 + kstep; const char* b3 = b2 + kstep;
            if (last && has_next) S.a_ready(nxt);
            if constexpr (SP2) {
            PG8_LDB(B0, 0, 0); PG8_LDB(B1, 0, 1); PG8_SCHED; PG8_LDA(At, 0, 0); PG8_STAGE(PG8_SA(1, 1), a1 + hstep, voffA);
            PG8_WAIT_V(8); PG8_WAIT_L(0); PG8_BAR; PG8_MMA(0, 0, At, B0); PG8_MMA(0, 1, At, B1); PG8_BAR; PG8_SCHED;
            PG8_LDA(At, 0, 1); PG8_STAGE(PG8_SB(0, 0), b2, voffB); PG8_STAGE(PG8_SB(0, 1), b2 + hstep, voffB); PG8_STAGE(PG8_SA(0, 0), a2, voffA);
            PG8_WAIT_V(8); PG8_WAIT_L(0); PG8_BAR; PG8_MMA(1, 0, At, B0); PG8_MMA(1, 1, At, B1); PG8_BAR; PG8_SCHED;
            PG8_LDB(B0, 1, 0); PG8_LDB(B1, 1, 1); PG8_SCHED; PG8_LDA(At, 1, 0); PG8_STAGE(PG8_SA(0, 1), a2 + hstep, voffA);
            PG8_WAIT_V(8); PG8_WAIT_L(0); PG8_BAR; PG8_MMA(0, 0, At, B0); PG8_MMA(0, 1, At, B1); PG8_BAR; PG8_SCHED;
            PG8_LDA(At, 1, 1); PG8_STAGE(PG8_SB(1, 0), b3, voffB); PG8_STAGE(PG8_SB(1, 1), b3 + hstep, voffB); PG8_STAGE(PG8_SA(1, 0), a3, voffA);
            PG8_WAIT_V(8); PG8_WAIT_L(0); PG8_BAR; PG8_MMA(1, 0, At, B0); PG8_MMA(1, 1, At, B1); PG8_BAR; PG8_SCHED;
            } else {
            PG8_LDB(B0, 0, 0); PG8_SCHED; PG8_LDA(At, 0, 0); PG8_STAGE(PG8_SA(1, 1), a1 + hstep, voffA);
            PG8_WAIT_L(8); PG8_BAR; PG8_WAIT_L(0); PG8_MMA(0, 0, At, B0); PG8_BAR; PG8_SCHED;
            PG8_LDB(B1, 0, 1); PG8_STAGE(PG8_SB(0, 0), b2, voffB);
            PG8_BAR; PG8_WAIT_L(0); PG8_MMA(0, 1, At, B1); PG8_BAR;
            PG8_LDA(At, 0, 1); PG8_STAGE(PG8_SA(0, 0), a2, voffA);
            PG8_BAR; PG8_WAIT_L(0); PG8_MMA(1, 0, At, B0); PG8_BAR; PG8_SCHED;
            PG8_STAGE(PG8_SB(0, 1), b2 + hstep, voffB);
            PG8_WAIT_V(6); PG8_BAR; PG8_MMA(1, 1, At, B1); PG8_BAR;
            PG8_LDB(B0, 1, 0); PG8_SCHED; PG8_LDA(At, 1, 0); PG8_STAGE(PG8_SA(0, 1), a2 + hstep, voffA);
            PG8_WAIT_L(8); PG8_BAR; PG8_WAIT_L(0); PG8_MMA(0, 0, At, B0); PG8_BAR; PG8_SCHED;
            PG8_LDB(B1, 1, 1); PG8_STAGE(PG8_SB(1, 0), b3, voffB);
            PG8_BAR; PG8_WAIT_L(0); PG8_MMA(0, 1, At, B1); PG8_BAR;
            PG8_LDA(At, 1, 1); PG8_STAGE(PG8_SA(1, 0), a3, voffA);
            PG8_BAR; PG8_WAIT_L(0); PG8_MMA(1, 0, At, B0); PG8_BAR; PG8_SCHED;
            PG8_STAGE(PG8_SB(1, 1), b3 + hstep, voffB);
            PG8_WAIT_V(6); PG8_BAR; PG8_MMA(1, 1, At, B1); PG8_BAR;
            }
        }
        if constexpr (ALIGN_EPI) { if (wr == 0) PG8_BAR; }
        if constexpr (!Epi::AFTER_DRAIN) { E(acc, cur, wr, wc, fr, fq); S.done(cur); }
        if (!has_next) break;
#pragma unroll
        for (int a = 0; a < 2; ++a)
#pragma unroll
            for (int b = 0; b < 2; ++b)
#pragma unroll
                for (int m = 0; m < 4; ++m)
#pragma unroll
                    for (int n = 0; n < 2; ++n) acc[a][b][m][n] = (f32x4){0.f, 0.f, 0.f, 0.f};
        cur = nxt; cA = nA; cB = nB; ++ui;
        if constexpr (ALIGN_EPI) { if (wr == 1) PG8_BAR; }
    }
    PG8_WAIT_V(0);
    if constexpr (!ALIGN_EPI) { if (wr == 0) PG8_BAR; }
    PG8_BAR;
    if constexpr (Epi::AFTER_DRAIN) { E.fused(acc, cur, wr, wc, fr, fq, lds, wid, lane); S.done(cur); }
#undef PG8_SA
#undef PG8_SB
#undef PG8_STAGE
#undef PG8_LDA
#undef PG8_LDB
#undef PG8_MMA
#undef PG8_WAIT_V
#undef PG8_WAIT_L
#undef PG8_BAR
#undef PG8_SCHED
}
}

constexpr int NB = 4, SEQ = 4096, D = 1024, M = NB * SEQ, NIN = 1536, PW = 512, LW = 512, DFF = 2816, NGU = 2 * DFF;
constexpr float EPS = 1e-6f;
constexpr int MT = 2, CH = 16 * MT, NCHUNK = SEQ / CH, NT2 = NB * NCHUNK;
constexpr int NWAVES = 8;
constexpr int LDS_BYTES = 147456;

constexpr size_t KiB = 1024, MiB = 1u << 20;
constexpr size_t WS_SS2 = 0, WS_SS3 = 64 * KiB, WS_NSP = 128 * KiB;
constexpr size_t WS_BAR = 192 * KiB, BAR_BYTES = 16 * KiB;
constexpr size_t WS_POOLWT = 256 * KiB, WS_WAT = 384 * KiB, WS_WIT = 448 * KiB;
constexpr size_t WS_AGGA = 1 * MiB, WS_AGGB = 1 * MiB + 512 * KiB;
constexpr size_t WS_WIN = 2 * MiB, WS_WOUT = 5 * MiB, WS_WGU = 7 * MiB, WS_WD = 18 * MiB;
constexpr size_t WS_X1 = 24 * MiB;
constexpr size_t WS_X2 = 56 * MiB;
constexpr size_t WS_ACT = 104 * MiB;
constexpr size_t WS_END = 192 * MiB;
static_assert(WS_WD + (size_t)D * DFF * 2 <= WS_X1 && WS_X1 + (size_t)M * D * 2 <= WS_X2 && WS_X2 + (size_t)M * NIN * 2 <= WS_ACT && WS_ACT + (size_t)M * DFF * 2 <= WS_END, "d_ws map");

#define LAS __attribute__((address_space(3)))
typedef unsigned short bf16;
typedef float f32x4 __attribute__((ext_vector_type(4)));
typedef short bf16x8 __attribute__((ext_vector_type(8)));
typedef unsigned u32x4 __attribute__((ext_vector_type(4)));
typedef unsigned u32x2 __attribute__((ext_vector_type(2)));
#define LDS_WAIT() asm volatile("s_waitcnt lgkmcnt(0)" ::: "memory")

__device__ __forceinline__ unsigned pk2(float lo, float hi) { unsigned r; asm volatile("v_cvt_pk_bf16_f32 %0, %1, %2" : "=v"(r) : "v"(lo), "v"(hi)); return r; }
__device__ __forceinline__ f32x4 bf4_to_f32(u32x2 v) { f32x4 r; r[0] = __uint_as_float(v.x << 16); r[1] = __uint_as_float(v.x & 0xffff0000u); r[2] = __uint_as_float(v.y << 16); r[3] = __uint_as_float(v.y & 0xffff0000u); return r; }
__device__ __forceinline__ float wave_sum(float v) {
#pragma unroll
    for (int o = 1; o < 64; o <<= 1) v += __shfl_xor(v, o);
    return v;
}
template <int CTRL> __device__ __forceinline__ float dpp_f(float old, float src) { return __int_as_float(__builtin_amdgcn_update_dpp(__float_as_int(old), __float_as_int(src), CTRL, 0xf, 0xf, false)); }
__device__ __forceinline__ float sigmoidf_(float x) { return __builtin_amdgcn_rcpf(1.0f + __expf(-x)); }

__device__ __forceinline__ void tr_item(const float* W, int N, int k0, int n0, bf16* dst, int ldk, LAS float* scr, int lane) {
#pragma unroll 8
    for (int i = 0; i < 32; ++i) { const int kk = 2 * i + (lane >> 5); scr[kk * 33 + (lane & 31)] = W[(size_t)(k0 + kk) * N + n0 + (lane & 31)]; }
    LDS_WAIT();
    const int c = lane & 7;
#pragma unroll
    for (int j = 0; j < 4; ++j) { const int n = (lane >> 3) + 8 * j; const LAS float* s = scr + (8 * c) * 33 + n;
        u32x4 o; o.x = pk2(s[0 * 33], s[1 * 33]); o.y = pk2(s[2 * 33], s[3 * 33]); o.z = pk2(s[4 * 33], s[5 * 33]); o.w = pk2(s[6 * 33], s[7 * 33]);
        *(u32x4*)(dst + (size_t)n * ldk + 8 * c) = o; }
    LDS_WAIT();
}

#define XB_TMO      128
#define XB_XCNT(j)  (256  + 64 * (j))
#define XB_XSUB(j)  (1280 + 64 * (j))
#define XB_XGEN(j)  (2304 + 64 * (j))
#define XB_TOP      3328
#define XB_TOPGEN   3392
#define XCD_BAR_WORDS 3456
#define XB_SPIN_CAP (1u << 18)

__device__ __forceinline__ unsigned xb_ld(unsigned* p)              { return __hip_atomic_load(p, __ATOMIC_RELAXED, __HIP_MEMORY_SCOPE_AGENT); }
__device__ __forceinline__ unsigned xb_add(unsigned* p, unsigned v) { return __hip_atomic_fetch_add(p, v, __ATOMIC_RELAXED, __HIP_MEMORY_SCOPE_AGENT); }
__device__ __forceinline__ unsigned xb_xcc_id() { return (unsigned)__builtin_amdgcn_s_getreg((3 << 11) | 20) & 0xFu; }
#define XB_SPIN(cond, bar) do { unsigned _sp = 0; while (cond) { __builtin_amdgcn_s_sleep(1); \
    if ((++_sp & 255u) == 0u) { if (xb_ld(&(bar)[XB_TMO])) break; if (_sp > XB_SPIN_CAP) { atomicAdd(&(bar)[XB_TMO], 1u); break; } } } } while (0)

struct XcdBarrier {
    unsigned* bar; unsigned x;
    volatile LAS unsigned* st;
};

__device__ __forceinline__ XcdBarrier xcd_barrier_post(unsigned* bar, volatile LAS unsigned* st) {
    XcdBarrier b; b.bar = bar; b.x = xb_xcc_id(); b.st = st;
    if (threadIdx.x == 0) (void)xb_add(&bar[XB_XCNT(b.x)], 1u);
    return b;
}
__device__ __forceinline__ void xcd_barrier_complete(unsigned* bar, unsigned x, unsigned& nloc, unsigned& nx) {
    const unsigned G = gridDim.x * gridDim.y * gridDim.z;
    unsigned sum, cnt, mine, sp = 0u;
    for (;;) {
        sum = 0u; cnt = 0u; mine = 0u;
#pragma unroll
        for (unsigned j = 0; j < 16; ++j) { const unsigned c = xb_ld(&bar[XB_XCNT(j)]); sum += c; cnt += (c > 0u) ? 1u : 0u; mine = (j == x) ? c : mine; }
        if (sum == G) break;
        __builtin_amdgcn_s_sleep(1);
        if ((++sp & 255u) == 0u) { if (xb_ld(&bar[XB_TMO])) break; if (sp > XB_SPIN_CAP) { atomicAdd(&bar[XB_TMO], 1u); break; } }
    }
    nloc = mine > 0u ? mine : 1u; nx = cnt > 0u ? cnt : 1u;
}

__device__ __forceinline__ void xcd_barrier(const XcdBarrier& b) {
    asm volatile("s_waitcnt vmcnt(0)" ::: "memory");
    __syncthreads();
    if (threadIdx.x == 0) {
        unsigned* bar = b.bar;
        __builtin_amdgcn_s_waitcnt(0);
        unsigned nloc = b.st[0], nx = b.st[1];
        if (nloc == 0u) { xcd_barrier_complete(bar, b.x, nloc, nx); b.st[0] = nloc; b.st[1] = nx; }
        const unsigned old = xb_add(&bar[XB_XSUB(b.x)], 1u);
        const unsigned gen = old / nloc;
        if (old + 1u == (gen + 1u) * nloc) {
            __builtin_amdgcn_fence(__ATOMIC_RELEASE, "agent");
            asm volatile("s_waitcnt vmcnt(0)" ::: "memory");
            const unsigned og = xb_add(&bar[XB_TOP], 1u);
            const unsigned tg = og / nx;
            if (og + 1u == (tg + 1u) * nx) xb_add(&bar[XB_TOPGEN], 1u);
            else XB_SPIN(xb_ld(&bar[XB_TOPGEN]) == tg, bar);
            __builtin_amdgcn_fence(__ATOMIC_ACQUIRE, "agent");
            xb_add(&bar[XB_XGEN(b.x)], 1u);
            asm volatile("s_waitcnt vmcnt(0)" ::: "memory");
        } else {
            XB_SPIN(xb_ld(&bar[XB_XGEN(b.x)]) == gen, bar);
            __builtin_amdgcn_fence(__ATOMIC_ACQUIRE, "agent");
            asm volatile("s_waitcnt vmcnt(0)" ::: "memory");
        }
    }
    __syncthreads();
}

struct Args { const float* in[20]; float* out; unsigned char* ws; };

__global__ void __launch_bounds__(NWAVES * 64, 2) fwd_kernel(Args args) {
    extern __shared__ __attribute__((aligned(16))) unsigned char lds_raw[];
    cg::grid_group grid = cg::this_grid();
    LAS unsigned char* lds = (LAS unsigned char*)lds_raw;
    const int tid = threadIdx.x, lane = tid & 63, wave = __builtin_amdgcn_readfirstlane(tid >> 6), fr_k = lane & 15, fq_k = lane >> 4, lane_k = lane;
    const int G = gridDim.x, bid = blockIdx.x, gw = bid * NWAVES + wave, NGW = G * NWAVES;
    unsigned char* ws = args.ws;
    volatile LAS unsigned* MISC = (volatile LAS unsigned*)(lds + LDS_BYTES - 64);
    if (tid < 16) MISC[tid] = 0u;
    __syncthreads();
    XcdBarrier xbar = xcd_barrier_post((unsigned*)(ws + WS_BAR), MISC);
    if (gridDim.y == 7777u) grid.sync();
#define GRID_BAR() xcd_barrier(xbar)
    const float* x = args.in[0]; const float* ln1_g = args.in[1]; const float* w_in = args.in[2]; const float* pool_w = args.in[3]; const float* pool_scale = args.in[4];
    const float* conv_w = args.in[5]; const float* conv_b = args.in[6]; const float* w_a = args.in[7]; const float* b_a = args.in[8]; const float* w_i = args.in[9]; const float* b_i = args.in[10];
    const float* lam = args.in[11]; const float* gn_pool_g = args.in[12]; const float* gn_lru_g = args.in[13]; const float* w_out = args.in[14]; const float* ln2_g = args.in[15];
    const float* w_gate = args.in[16]; const float* w_up = args.in[17]; const float* w_down = args.in[18]; const float* lnf_g = args.in[19];
    float* out = args.out;
    float* ss2 = (float*)(ws + WS_SS2); float* ss3 = (float*)(ws + WS_SS3); float* nsp = (float*)(ws + WS_NSP);
    bf16* poolwT = (bf16*)(ws + WS_POOLWT); bf16* waT = (bf16*)(ws + WS_WAT); bf16* wiT = (bf16*)(ws + WS_WIT);
    float* aggA = (float*)(ws + WS_AGGA); float* aggB = (float*)(ws + WS_AGGB);
    bf16* WinT = (bf16*)(ws + WS_WIN); bf16* WoutT = (bf16*)(ws + WS_WOUT); bf16* WguT = (bf16*)(ws + WS_WGU); bf16* WdT = (bf16*)(ws + WS_WD);
    bf16* xn = (bf16*)(ws + WS_X1); bf16* mix = (bf16*)(ws + WS_X1); bf16* proj = (bf16*)(ws + WS_X2); bf16* hb = (bf16*)(ws + WS_X2); bf16* act = (bf16*)(ws + WS_ACT);

#ifndef REP_P0
#define REP_P0 1
#endif
#ifndef REP_P1
#define REP_P1 1
#endif
#ifndef REP_P4
#define REP_P4 1
#endif
    for (int rep0 = 0; rep0 < REP_P0; ++rep0) {
        for (int i = bid * 512 + tid; i < 2 * M; i += G * 512) ss2[i] = 0.f;
        if (bid == 0) nsp[tid] = -8.0f * log1pf(expf(-lam[tid]));
        LAS float* scr = (LAS float*)(lds + wave * 16384);
        constexpr int I_IN = (D / 64) * (NIN / 32), I_OUT = (D / 64) * (D / 32), I_G = (D / 64) * (DFF / 32), I_D = (DFF / 64) * (D / 32), I_P = 4 * 2 * 4, I_A = 8 * 2;
        constexpr int NITEMS = I_IN + I_OUT + 2 * I_G + I_D + I_P + 2 * I_A;
        for (int it = gw; it < NITEMS; it += NGW) {
            int r = it;
            if (r < I_IN) { const int kb = r / (NIN / 32), nb = r % (NIN / 32); tr_item(w_in, NIN, 64 * kb, 32 * nb, WinT + (size_t)(32 * nb) * D + 64 * kb, D, scr, lane); continue; } r -= I_IN;
            if (r < I_OUT) { const int kb = r / (D / 32), nb = r % (D / 32); tr_item(w_out, D, 64 * kb, 32 * nb, WoutT + (size_t)(32 * nb) * D + 64 * kb, D, scr, lane); continue; } r -= I_OUT;
            if (r < 2 * I_G) { const int up = r >= I_G ? 1 : 0; r -= up * I_G; const int kb = r / (DFF / 32), nb = r % (DFF / 32), n0 = 32 * nb, drow = 256 * (n0 / 128) + (n0 % 128) + 128 * up;
                tr_item(up ? w_up : w_gate, DFF, 64 * kb, n0, WguT + (size_t)drow * D + 64 * kb, D, scr, lane); continue; } r -= 2 * I_G;
            if (r < I_D) { const int kb = r / (D / 32), nb = r % (D / 32); tr_item(w_down, D, 64 * kb, 32 * nb, WdT + (size_t)(32 * nb) * DFF + 64 * kb, DFF, scr, lane); continue; } r -= I_D;
            if (r < I_P) { const int g = r / 8, kb = (r % 8) / 4, nb = r % 4; tr_item(pool_w + g * 16384, 128, 64 * kb, 32 * nb, poolwT + g * 16384 + (32 * nb) * 128 + 64 * kb, 128, scr, lane); continue; } r -= I_P;
            { const int wi = r >= I_A ? 1 : 0; r -= wi * I_A; const int h = r / 2, nb = r % 2; tr_item((wi ? w_i : w_a) + h * 4096, 64, 0, 32 * nb, (wi ? wiT : waT) + h * 4096 + (32 * nb) * 64, 64, scr, lane); }
        }
        f32x4 gv[4];
#pragma unroll
        for (int j = 0; j < 4; ++j) gv[j] = ((const f32x4*)ln1_g)[lane + 64 * j];
        for (int m = gw; m < M; m += NGW) {
            const f32x4* xr = (const f32x4*)(x + (size_t)m * D) + lane; f32x4 v[4]; float s = 0.f;
#pragma unroll
            for (int j = 0; j < 4; ++j) { v[j] = xr[64 * j]; s += (v[j].x * v[j].x + v[j].y * v[j].y) + (v[j].z * v[j].z + v[j].w * v[j].w); }
            const float rs = __builtin_amdgcn_rsqf(wave_sum(s) * (1.f / D) + EPS);
            u32x2* o8 = (u32x2*)(xn + (size_t)m * D) + lane;
#pragma unroll
            for (int j = 0; j < 4; ++j) { const f32x4 y = (v[j] * rs) * gv[j]; u32x2 w; w.x = pk2(y.x, y.y); w.y = pk2(y.z, y.w); o8[64 * j] = w; }
        }
    }
    GRID_BAR();

#if !defined(SKIP_P1)
    for (int rep1 = 0; rep1 < REP_P1; ++rep1) {
        pg8::Gemm g{xn, WinT, M, NIN, D}; pg8::StaticOrder S; S.init(M, NIN, G, bid);
        pg8::EpiStoreBf16 E{proj, NIN};
        pg8::gemm_phase<pg8::EpiStoreBf16, pg8::StaticOrder, true, true>(lds, g, S, E);
    }
    GRID_BAR();

#endif
#if !defined(SKIP_P2)
    {
        constexpr int PSTR = 1040;
        constexpr int XSTR = 144, XWAVE = CH * XSTR;
        constexpr int RED_OFF = 80 * 1024, RED2_OFF = 82 * 1024;
        LAS float* red = (LAS float*)(lds + RED_OFF); LAS float* red2 = (LAS float*)(lds + RED2_OFF); LAS float* cyl = (LAS float*)(lds + RED2_OFF + 2048);
#ifndef REP_P2
#define REP_P2 1
#endif
        for (int rep2 = 0; rep2 < REP_P2; ++rep2)
        for (int base = 0; base < NT2; base += G) {
            const int tile = base + bid; const bool active = tile < NT2;
            const int bidx = tile / NCHUNK, cidx = tile % NCHUNK, t0 = cidx * CH; const size_t rowb = (size_t)bidx * SEQ;
            int fr = fr_k, fq = fq_k, lane = lane_k; asm volatile("" : "+v"(fr), "+v"(fq), "+v"(lane));
            const int h = wave, chl = h * 64 + 4 * fq;
            f32x4 xc[MT][4], av[MT][4];
            if (active) {
#if !defined(SKIP_POOL)
#pragma unroll
                for (int g = 0; g < 4; ++g) {
                    const int W = 2 << g;
#pragma unroll
                    for (int it = 0; it < MT / 2; ++it) {
                        const int tl = wave * (2 * MT) + it * 4 + (lane >> 4), cv = lane & 15, ch = g * 128 + cv * 8, pos = t0 + tl;
                        const bf16* p = proj + (rowb + pos) * NIN + ch;
                        const u32x4 c = *(const u32x4*)p;
                        float s[8], c8[8];
#pragma unroll
                        for (int e = 0; e < 4; ++e) { c8[2 * e] = __uint_as_float(c[e] << 16); c8[2 * e + 1] = __uint_as_float(c[e] & 0xffff0000u); s[2 * e] = c8[2 * e]; s[2 * e + 1] = c8[2 * e + 1]; }
#pragma unroll
                        for (int j = 1; j < W; ++j) { const int pj = pos - j; const float mk = pj >= 0 ? 1.f : 0.f; const u32x4 v = *(const u32x4*)(proj + (rowb + (pj >= 0 ? pj : 0)) * NIN + ch);
#pragma unroll
                            for (int e = 0; e < 4; ++e) { s[2 * e] += mk * __uint_as_float(v[e] << 16); s[2 * e + 1] += mk * __uint_as_float(v[e] & 0xffff0000u); } }
                        const float inv = 1.0f / (float)(pos + 1 < W ? pos + 1 : W);
                        u32x4 o;
#pragma unroll
                        for (int e = 0; e < 4; ++e) o[e] = pk2(s[2 * e] * inv - c8[2 * e], s[2 * e + 1] * inv - c8[2 * e + 1]);
                        *(LAS u32x4*)(lds + tl * PSTR + ch * 2) = o;
                    }
                }
                {
                    const int g = wave >> 1, nh = wave & 1, chp = g * 128 + nh * 64 + 4 * fq;
                    bf16x8 wf[4][4];
#pragma unroll
                    for (int n = 0; n < 4; ++n)
#pragma unroll
                        for (int ks = 0; ks < 4; ++ks) wf[n][ks] = *(const bf16x8*)(poolwT + (size_t)(g * 128 + nh * 64 + n * 16 + fr) * 128 + ks * 32 + fq * 8);
                    __syncthreads();
                    f32x4 acc[MT][4];
#pragma unroll
                    for (int m = 0; m < MT; ++m)
#pragma unroll
                        for (int n = 0; n < 4; ++n) acc[m][n] = (f32x4){0.f, 0.f, 0.f, 0.f};
#pragma unroll
                    for (int m = 0; m < MT; ++m)
#pragma unroll
                        for (int ks = 0; ks < 4; ++ks) { const bf16x8 xf = *(const LAS bf16x8*)(lds + (16 * m + fr) * PSTR + (g * 128 + ks * 32 + fq * 8) * 2);
#pragma unroll
                            for (int n = 0; n < 4; ++n) acc[m][n] = __builtin_amdgcn_mfma_f32_16x16x32_bf16(wf[n][ks], xf, acc[m][n], 0, 0, 0); }
                    f32x4 psc[4], pg[4];
#pragma unroll
                    for (int n = 0; n < 4; ++n) { psc[n] = *(const f32x4*)(pool_scale + chp + 16 * n); pg[n] = *(const f32x4*)(gn_pool_g + chp + 16 * n); }
#pragma unroll
                    for (int m = 0; m < MT; ++m) { float ss = 0.f;
#pragma unroll
                        for (int n = 0; n < 4; ++n) { acc[m][n] = acc[m][n] * psc[n]; const f32x4 y = acc[m][n]; ss += (y[0] * y[0] + y[1] * y[1]) + (y[2] * y[2] + y[3] * y[3]); }
                        ss += __shfl_xor(ss, 16); ss += __shfl_xor(ss, 32);
                        if (fq == 0) red[(16 * m + fr) * 8 + wave] = ss; }
                    __syncthreads();
#pragma unroll
                    for (int m = 0; m < MT; ++m) { const f32x4 r0 = *(const LAS f32x4*)(red + (16 * m + fr) * 8), r1 = *(const LAS f32x4*)(red + (16 * m + fr) * 8 + 4);
                        const float tot = ((r0[0] + r0[1]) + (r0[2] + r0[3])) + ((r1[0] + r1[1]) + (r1[2] + r1[3]));
                        const float rs = __builtin_amdgcn_rsqf(tot * (1.f / PW) + EPS);
                        bf16* mp = mix + (rowb + t0 + 16 * m + fr) * D + chp;
#pragma unroll
                        for (int n = 0; n < 4; ++n) { const f32x4 y = (acc[m][n] * rs) * pg[n]; u32x2 w; w.x = pk2(y[0], y[1]); w.y = pk2(y[2], y[3]); *(u32x2*)(mp + 16 * n) = w; } }
                }
#endif
                LAS unsigned char* lx = lds + wave * XWAVE;
#pragma unroll
                for (int n = 0; n < 4; ++n) {
                    const int chn = chl + 16 * n;
                    f32x4 cw[4];
#pragma unroll
                    for (int k = 0; k < 4; ++k) cw[k] = *(const f32x4*)(conv_w + k * LW + chn);
                    const f32x4 cb = *(const f32x4*)(conv_b + chn);
                    f32x4 u[MT + 3];
#pragma unroll
                    for (int r = 0; r < MT + 3; ++r) { const int pos = t0 + MT * fr - 3 + r; const u32x2 raw = *(const u32x2*)(proj + (rowb + (pos >= 0 ? pos : 0)) * NIN + PW + chn);
                        u[r] = bf4_to_f32(raw); if (pos < 0) u[r] = (f32x4){0.f, 0.f, 0.f, 0.f}; }
#pragma unroll
                    for (int m = 0; m < MT; ++m) { const f32x4 v = cb + cw[0] * u[m] + cw[1] * u[m + 1] + cw[2] * u[m + 2] + cw[3] * u[m + 3]; xc[m][n] = v;
                        u32x2 w; w.x = pk2(v[0], v[1]); w.y = pk2(v[2], v[3]); *(LAS u32x2*)(lx + (m * 16 + fr) * XSTR + (n * 16 + 4 * fq) * 2) = w; }
                }
                LDS_WAIT();
#pragma unroll
                for (int n = 0; n < 4; ++n) {
                    const int chn = chl + 16 * n;
                    bf16x8 waf[2], wif[2];
#pragma unroll
                    for (int ks = 0; ks < 2; ++ks) { waf[ks] = *(const bf16x8*)(waT + (size_t)(h * 64 + n * 16 + fr) * 64 + ks * 32 + fq * 8); wif[ks] = *(const bf16x8*)(wiT + (size_t)(h * 64 + n * 16 + fr) * 64 + ks * 32 + fq * 8); }
                    const f32x4 ba = *(const f32x4*)(b_a + chn), bi = *(const f32x4*)(b_i + chn), sp = *(const f32x4*)(nsp + chn);
#pragma unroll
                    for (int m = 0; m < MT; ++m) {
                            const bf16x8 xf0 = *(const LAS bf16x8*)(lx + (m * 16 + fr) * XSTR + (fq * 8) * 2), xf1 = *(const LAS bf16x8*)(lx + (m * 16 + fr) * XSTR + (32 + fq * 8) * 2);
                        f32x4 ra = (f32x4){0.f, 0.f, 0.f, 0.f}, ia = (f32x4){0.f, 0.f, 0.f, 0.f};
                        ra = __builtin_amdgcn_mfma_f32_16x16x32_bf16(waf[0], xf0, ra, 0, 0, 0); ra = __builtin_amdgcn_mfma_f32_16x16x32_bf16(waf[1], xf1, ra, 0, 0, 0);
                        ia = __builtin_amdgcn_mfma_f32_16x16x32_bf16(wif[0], xf0, ia, 0, 0, 0); ia = __builtin_amdgcn_mfma_f32_16x16x32_bf16(wif[1], xf1, ia, 0, 0, 0);
#pragma unroll
                        for (int j = 0; j < 4; ++j) { const float rr = sigmoidf_(ra[j] + ba[j]), ii = sigmoidf_(ia[j] + bi[j]); const float la = rr * sp[j];
                            const float a = __expf(la), x2 = 2.0f * la;
                            const float pl = -x2 * (1.0f + x2 * (0.5f + x2 * (0.16666667f + x2 * (0.041666668f + x2 * (0.0083333338f + x2 * (0.0013888889f + x2 * 0.0001984127f))))));
                            const float mult = __builtin_amdgcn_sqrtf(fmaxf(x2 > -0.25f ? pl : 1.0f - a * a, 0.0f));
                            av[m][n][j] = a; xc[m][n][j] = mult * ii * xc[m][n][j]; }
                    }
                }
#pragma unroll
                for (int n = 0; n < 4; ++n)
#pragma unroll
                    for (int j = 0; j < 4; ++j) {
#pragma unroll
                        for (int m = 1; m < MT; ++m) { xc[m][n][j] = av[m][n][j] * xc[m - 1][n][j] + xc[m][n][j]; av[m][n][j] = av[m][n][j] * av[m - 1][n][j]; }
                        float Pi = av[MT - 1][n][j], Hi = xc[MT - 1][n][j], ap, hp;
                        ap = dpp_f<0x111>(1.0f, Pi); hp = dpp_f<0x111>(0.0f, Hi); Hi = Pi * hp + Hi; Pi = Pi * ap;
                        ap = dpp_f<0x112>(1.0f, Pi); hp = dpp_f<0x112>(0.0f, Hi); Hi = Pi * hp + Hi; Pi = Pi * ap;
                        ap = dpp_f<0x114>(1.0f, Pi); hp = dpp_f<0x114>(0.0f, Hi); Hi = Pi * hp + Hi; Pi = Pi * ap;
                        ap = dpp_f<0x118>(1.0f, Pi); hp = dpp_f<0x118>(0.0f, Hi); Hi = Pi * hp + Hi; Pi = Pi * ap;
                        const float Pe = dpp_f<0x111>(1.0f, Pi), He = dpp_f<0x111>(0.0f, Hi);
#pragma unroll
                        for (int m = 0; m < MT; ++m) { xc[m][n][j] = xc[m][n][j] + av[m][n][j] * He; av[m][n][j] = av[m][n][j] * Pe; }
                    }
                if (fr == 15) {
#pragma unroll
                    for (int n = 0; n < 4; ++n) { *(f32x4*)(aggA + (size_t)tile * LW + chl + 16 * n) = av[MT - 1][n]; *(f32x4*)(aggB + (size_t)tile * LW + chl + 16 * n) = xc[MT - 1][n]; }
                }
            }
            GRID_BAR();
            if (active) {
                {
                    const int seg = tid >> 7, c4 = (tid & 127) * 4, per = (cidx + 3) >> 2, j0 = seg * per, j1 = (j0 + per < cidx) ? j0 + per : cidx;
                    f32x4 cA = (f32x4){1.f, 1.f, 1.f, 1.f}, cB = (f32x4){0.f, 0.f, 0.f, 0.f};
                    const float* pa = aggA + (size_t)(bidx * NCHUNK) * LW + c4; const float* pb = aggB + (size_t)(bidx * NCHUNK) * LW + c4;
#pragma unroll 8
                    for (int jc = j0; jc < j1; ++jc) { const f32x4 A = *(const f32x4*)(pa + (size_t)jc * LW), B = *(const f32x4*)(pb + (size_t)jc * LW); cB = A * cB + B; cA = A * cA; }
                    *(LAS f32x4*)(cyl + seg * 1024 + c4) = cA; *(LAS f32x4*)(cyl + seg * 1024 + 512 + c4) = cB;
                }
                __syncthreads();
                f32x4 carry[4];
#pragma unroll
                for (int n = 0; n < 4; ++n) { f32x4 cy = *(const LAS f32x4*)(cyl + 512 + chl + 16 * n);
#pragma unroll
                    for (int sg = 1; sg < 4; ++sg) cy = *(const LAS f32x4*)(cyl + sg * 1024 + chl + 16 * n) * cy + *(const LAS f32x4*)(cyl + sg * 1024 + 512 + chl + 16 * n);
                    carry[n] = cy; }
                f32x4 gl[4];
#pragma unroll
                for (int n = 0; n < 4; ++n) gl[n] = *(const f32x4*)(gn_lru_g + chl + 16 * n);
#pragma unroll
                for (int m = 0; m < MT; ++m) { float ss = 0.f; const bf16* gp = proj + (rowb + t0 + MT * fr + m) * NIN + PW + LW + chl;
#pragma unroll
                    for (int n = 0; n < 4; ++n) { const f32x4 hh = xc[m][n] + av[m][n] * carry[n]; const f32x4 gt = bf4_to_f32(*(const u32x2*)(gp + 16 * n)); f32x4 y;
#pragma unroll
                        for (int j = 0; j < 4; ++j) { const float z = gt[j]; y[j] = hh[j] * z * sigmoidf_(1.5957691216f * (z + 0.044715f * z * z * z)); }
                        xc[m][n] = y; ss += (y[0] * y[0] + y[1] * y[1]) + (y[2] * y[2] + y[3] * y[3]); }
                    ss += __shfl_xor(ss, 16); ss += __shfl_xor(ss, 32);
                    if (fq == 0) red2[(MT * fr + m) * 8 + wave] = ss; }
                __syncthreads();
#pragma unroll
                for (int m = 0; m < MT; ++m) { const f32x4 r0 = *(const LAS f32x4*)(red2 + (MT * fr + m) * 8), r1 = *(const LAS f32x4*)(red2 + (MT * fr + m) * 8 + 4);
                    const float tot = ((r0[0] + r0[1]) + (r0[2] + r0[3])) + ((r1[0] + r1[1]) + (r1[2] + r1[3]));
                    const float rs = __builtin_amdgcn_rsqf(tot * (1.f / LW) + EPS);
                    bf16* mp = mix + (rowb + t0 + MT * fr + m) * D + PW + chl;
#pragma unroll
                    for (int n = 0; n < 4; ++n) { const f32x4 y = (xc[m][n] * rs) * gl[n]; u32x2 w; w.x = pk2(y[0], y[1]); w.y = pk2(y[2], y[3]); *(u32x2*)(mp + 16 * n) = w; } }
                __syncthreads();
            }
        }
    }
    GRID_BAR();

#endif
#if !defined(SKIP_P3)
#ifdef EXTRA_SYNCS
    for (int es = 0; es < EXTRA_SYNCS; ++es) grid.sync();
#endif
    {
        pg8::Gemm g{mix, WoutT, M, D, D}; pg8::StaticOrder S; S.init(M, D, G, bid);
        pg8::EpiResid<true> E{x, out, hb, ln2_g, ss2, D};
        pg8::gemm_phase<pg8::EpiResid<true>, pg8::StaticOrder, true, true>(lds, g, S, E);
    }
    GRID_BAR();

#endif
#if !defined(SKIP_P4)
    for (int rep4 = 0; rep4 < REP_P4; ++rep4) {
        pg8::Gemm g{hb, WguT, M, NGU, D}; pg8::StaticOrder S; S.init(M, NGU, G, bid);
        pg8::EpiSwiGLU E{act, DFF, ss2, 1.f / D, EPS};
        pg8::gemm_phase<pg8::EpiSwiGLU, pg8::StaticOrder, true, true>(lds, g, S, E);
    }
    GRID_BAR();

#endif
#if !defined(SKIP_P5)
    {
        pg8::Gemm g{act, WdT, M, D, DFF}; pg8::StaticOrder S; S.init(M, D, G, bid);
        pg8::EpiResid<false> E{out, out, nullptr, nullptr, ss3, D};
        pg8::gemm_phase<pg8::EpiResid<false>, pg8::StaticOrder, true, true>(lds, g, S, E);
    }
    GRID_BAR();

#endif
    {
        f32x4 gv[4];
#pragma unroll
        for (int j = 0; j < 4; ++j) gv[j] = ((const f32x4*)lnf_g)[lane + 64 * j];
        for (int m = gw; m < M; m += NGW) {
            f32x4* xr = (f32x4*)(out + (size_t)m * D) + lane;
            const float rs = __builtin_amdgcn_rsqf(ss3[m] * (1.f / D) + EPS);
#pragma unroll
            for (int j = 0; j < 4; ++j) { const f32x4 v = xr[64 * j]; xr[64 * j] = (v * rs) * gv[j]; }
        }
    }
}

extern "C" void kernel_launch(void* const* d_in, const int* in_sizes, int n_in, void* d_out, int out_size, void* d_ws, size_t ws_size, hipStream_t stream) {
    static int grid = 0;
    if (grid == 0) {
        if (n_in != 20 || in_sizes[0] != M * D || out_size != M * D || ws_size < WS_END) { fprintf(stderr, "kernel_launch: unexpected shapes (n_in %d, in0 %d, out %d, ws %zu)\n", n_in, n_in > 0 ? in_sizes[0] : -1, out_size, ws_size); grid = -1; return; }
        int dev = 0, cus = 0, per_cu = 0;
        (void)hipGetDevice(&dev); (void)hipDeviceGetAttribute(&cus, hipDeviceAttributeMultiprocessorCount, dev);
        if (hipFuncSetAttribute((const void*)fwd_kernel, hipFuncAttributeMaxDynamicSharedMemorySize, LDS_BYTES) != hipSuccess) { fprintf(stderr, "kernel_launch: hipFuncSetAttribute failed\n"); grid = -1; return; }
        if (hipOccupancyMaxActiveBlocksPerMultiprocessor(&per_cu, (const void*)fwd_kernel, NWAVES * 64, LDS_BYTES) != hipSuccess || per_cu < 1) per_cu = 1;
        (void)hipGetLastError();
        if (cus < 1) cus = 256;
        grid = cus * per_cu;
    }
    if (grid < 0) return;
    if (hipMemsetAsync((char*)d_ws + WS_BAR, 0, BAR_BYTES, stream) != hipSuccess) { fprintf(stderr, "kernel_launch: hipMemsetAsync failed\n"); return; }
    Args a{};
    for (int i = 0; i < 20; ++i) a.in[i] = (const float*)d_in[i];
    a.out = (float*)d_out; a.ws = (unsigned char*)d_ws;
    void* kargs[] = {&a};
    hipError_t e = hipLaunchCooperativeKernel((const void*)fwd_kernel, dim3(grid), dim3(NWAVES * 64), kargs, LDS_BYTES, stream);
    if (e != hipSuccess) fprintf(stderr, "kernel_launch: cooperative launch failed: %s (grid %d)\n", hipGetErrorString(e), grid);
}
```
